# Optimizing an MI355X kernel written in HIP

```python
import math
import jax, jax.numpy as jnp
from jax import lax
import numpy as np

D_MODEL = 1024
BATCH = 16
SEQ = 256
DEPTH = 2
DEC_BATCH = 4
DEC_SEQ = 4096
PAST_LEN = 512

GRID_W = 64
N_DIR = 2
CHUNK = 64
Q_BLOCK = 128
ROPE_BASE = 10000.0
EPS = 1e-6

A_HEADS = 4
A_QK_DIM = 64
A_V_DIM = 2 * A_QK_DIM
A_WIDTH = A_HEADS * A_V_DIM
A_QK_COLS = A_HEADS * 2 * A_QK_DIM
B_HEADS = 4
B_DIM = 64
B_WIDTH = B_HEADS * B_DIM
CONV_K = 5
C_HEADS = 4
C_DIM = 64
C_WIDTH = C_HEADS * C_DIM

MIX_WIDTH = A_WIDTH + B_WIDTH + C_WIDTH
IN_SIZES = (A_QK_COLS, A_QK_COLS, A_WIDTH,
            B_WIDTH, B_WIDTH, B_WIDTH, B_WIDTH, N_DIR * B_HEADS, N_DIR * B_HEADS,
            C_WIDTH, C_WIDTH, C_WIDTH, C_WIDTH, N_DIR * C_HEADS, N_DIR * C_HEADS)
IN_WIDTH = 2 * A_QK_COLS + A_WIDTH + 4 * B_WIDTH + 2 * N_DIR * B_HEADS + 4 * C_WIDTH + 2 * N_DIR * C_HEADS
FFN_HIDDEN = -((-8 * D_MODEL) // (3 * 256)) * 256

kernel_name = 'hybrid_diffusion_step'


def rms_norm(x, g):
    xf = x.astype(jnp.float32)
    y = xf * lax.rsqrt(jnp.mean(xf * xf, axis=-1, keepdims=True) + EPS)
    return (y * g.astype(jnp.float32)).astype(x.dtype)


def l2_norm(x):
    xf = x.astype(jnp.float32)
    return (xf * lax.rsqrt(jnp.sum(xf * xf, axis=-1, keepdims=True) + EPS)).astype(x.dtype)


def ada_mod(cvec, w, b):
    m = jnp.matmul(jax.nn.silu(cvec), w) + b
    return jnp.split(m, 6, axis=-1)


def swiglu(u, w_gu, w_dn):
    gate, up = jnp.split(jnp.einsum('bld,df->blf', u, w_gu), 2, axis=-1)
    return jnp.einsum('blf,fd->bld', jax.nn.silu(gate) * up, w_dn)


def axial_rope(x):
    L = x.shape[1]
    n_rows = L // GRID_W
    rows = jnp.repeat(jnp.arange(n_rows, dtype=jnp.float32), GRID_W)
    cols = jnp.tile(jnp.arange(GRID_W, dtype=jnp.float32), n_rows)
    n_freq = A_QK_DIM // 4
    inv_freq = ROPE_BASE ** (-jnp.arange(n_freq, dtype=jnp.float32) / n_freq)
    ang = jnp.concatenate([rows[:, None] * inv_freq, cols[:, None] * inv_freq], axis=-1)
    cos = jnp.cos(ang)[None, :, None, None, :].astype(x.dtype)
    sin = jnp.sin(ang)[None, :, None, None, :].astype(x.dtype)
    xp = x.reshape(x.shape[:-1] + (A_QK_DIM // 2, 2))
    x0, x1 = xp[..., 0], xp[..., 1]
    return jnp.stack([x0 * cos - x1 * sin, x0 * sin + x1 * cos], axis=-1).reshape(x.shape)


def centred_dwconv(x, w):
    return lax.conv_general_dilated(
        x, w[:, None, :].astype(x.dtype), window_strides=(1,),
        padding=[(CONV_K // 2, CONV_K // 2)], dimension_numbers=('NWC', 'WIO', 'NWC'),
        feature_group_count=x.shape[-1])


def diff_lambda(lqk, lam_init):
    lf = lqk.astype(jnp.float32)
    return jnp.exp(jnp.sum(lf[0] * lf[1])) - jnp.exp(jnp.sum(lf[2] * lf[3])) + lam_init


def diff_attention(q, k, v, lam):
    Bn, Lq = q.shape[:2]
    nb = Lq // Q_BLOCK
    qb = jnp.moveaxis(q.reshape((Bn, nb, Q_BLOCK) + q.shape[2:]), 1, 0)
    scale = A_QK_DIM ** -0.5

    def block(qi):
        s = jnp.einsum('bqhmd,bkhmd->bhmqk', qi, k).astype(jnp.float32) * scale
        p = jax.nn.softmax(s, axis=-1)
        w = p[:, :, 0] - lam * p[:, :, 1]
        return jnp.einsum('bhqk,bkhe->bqhe', w.astype(v.dtype), v)

    out = lax.map(block, qb)
    return jnp.moveaxis(out, 0, 1).reshape(Bn, Lq, A_HEADS, A_V_DIM)


def to_chunks(x):
    Bn, L, H = x.shape[:3]
    x = x.reshape((Bn, L // CHUNK, CHUNK, H) + x.shape[3:])
    return jnp.moveaxis(x, (1, 3), (0, 2))


def from_chunks(x):
    x = jnp.moveaxis(x, (0, 2), (1, 3))
    Bn, n, c, H, d = x.shape
    return x.reshape(Bn, n * c, H, d)


def chunk_masks():
    idx = jnp.arange(CHUNK)
    return idx[:, None] >= idx[None, :], idx[:, None] > idx[None, :]


def gated_delta_chunked(q, k, v, beta, g, s0):
    f32 = jnp.float32
    incl, strict = chunk_masks()
    q, k, v = to_chunks(q.astype(f32)), to_chunks(k.astype(f32)), to_chunks(v.astype(f32))
    beta, g = to_chunks(beta.astype(f32)), to_chunks(g.astype(f32))
    gc = jnp.cumsum(g, axis=-1)
    dd = gc[..., :, None] - gc[..., None, :]
    kb = k * beta[..., None]
    a_kk = jnp.einsum('nbhid,nbhjd->nbhij', kb, k) * jnp.exp(jnp.where(strict, dd, -jnp.inf))
    eye = jnp.eye(CHUNK, dtype=f32)
    t_mat = lax.linalg.triangular_solve(eye + a_kk, jnp.broadcast_to(eye, a_kk.shape),
                                        left_side=True, lower=True, unit_diagonal=True)
    u = jnp.matmul(t_mat, v * beta[..., None])
    w = jnp.matmul(t_mat, kb * jnp.exp(gc)[..., None])
    a_qk = jnp.einsum('nbhid,nbhjd->nbhij', q, k) * jnp.exp(jnp.where(incl, dd, -jnp.inf))
    q_dec = q * jnp.exp(gc)[..., None]
    k_dec = k * jnp.exp(gc[..., -1:] - gc)[..., None]
    g_last = jnp.exp(gc[..., -1])

    def step(S, inp):
        qd, kd, ui, wi, aqk, gl = inp
        v_new = ui - jnp.einsum('bhck,bhkv->bhcv', wi, S)
        o = jnp.einsum('bhck,bhkv->bhcv', qd, S) + jnp.einsum('bhcs,bhsv->bhcv', aqk, v_new)
        S = S * gl[..., None, None] + jnp.einsum('bhck,bhcv->bhkv', kd, v_new)
        return S, o

    S, o = lax.scan(step, s0.astype(f32), (q_dec, k_dec, u, w, a_qk, g_last))
    return from_chunks(o), S


def mlstm_chunked(q, k, v, ig, lf, c0, n0, m0):
    f32 = jnp.float32
    incl, _ = chunk_masks()
    q, k, v = to_chunks(q.astype(f32)), to_chunks(k.astype(f32)), to_chunks(v.astype(f32))
    ig, lf = to_chunks(ig.astype(f32)), to_chunks(lf.astype(f32))
    b = jnp.cumsum(lf, axis=-1)
    dmat = jnp.where(incl, b[..., :, None] - b[..., None, :] + ig[..., None, :], -jnp.inf)
    kv_log = b[..., -1:] - b + ig
    qk = jnp.einsum('nbhid,nbhjd->nbhij', q, k)

    def step(carry, inp):
        cs, ns, ms = carry
        qi, ki, vi, bi, di, kvl, qki = inp
        inter = bi + ms[..., None]
        m_t = jnp.maximum(inter, jnp.max(di, axis=-1))
        s = qki * jnp.exp(di - m_t[..., None])
        w_inter = jnp.exp(inter - m_t)
        num = w_inter[..., None] * jnp.einsum('bhcd,bhde->bhce', qi, cs) + jnp.einsum('bhcs,bhse->bhce', s, vi)
        den = w_inter * jnp.einsum('bhcd,bhd->bhc', qi, ns) + jnp.sum(s, axis=-1)
        h = num / jnp.maximum(jnp.abs(den), jnp.exp(-m_t))[..., None]
        bl = bi[..., -1]
        m_new = jnp.maximum(bl + ms, jnp.max(kvl, axis=-1))
        wk = jnp.exp(kvl - m_new[..., None])
        dec = jnp.exp(bl + ms - m_new)
        cs = dec[..., None, None] * cs + jnp.einsum('bhc,bhcd,bhce->bhde', wk, ki, vi)
        ns = dec[..., None] * ns + jnp.einsum('bhc,bhcd->bhd', wk, ki)
        return (cs, ns, m_new), h

    state, h = lax.scan(step, (c0.astype(f32), n0.astype(f32), m0.astype(f32)), (q, k, v, b, dmat, kv_log, qk))
    return from_chunks(h), state


def flip(x):
    return jnp.flip(x, axis=1)


def delta_bidir(q, k, v, beta, g, s0):
    o_f, s_f = gated_delta_chunked(q, k, v, beta[:, :, 0], g[:, :, 0], s0[:, 0])
    o_b, s_b = gated_delta_chunked(flip(q), flip(k), flip(v), flip(beta[:, :, 1]), flip(g[:, :, 1]), s0[:, 1])
    return (o_f + flip(o_b)).astype(v.dtype), jnp.stack([s_f, s_b], axis=1)


def mlstm_bidir(q, k, v, ig, lf, c0, n0, m0):
    h_f, st_f = mlstm_chunked(q, k, v, ig[:, :, 0], lf[:, :, 0], c0[:, 0], n0[:, 0], m0[:, 0])
    h_b, st_b = mlstm_chunked(flip(q), flip(k), flip(v), flip(ig[:, :, 1]), flip(lf[:, :, 1]),
                              c0[:, 1], n0[:, 1], m0[:, 1])
    states = (jnp.stack([st_f[0], st_b[0]], axis=1), jnp.stack([st_f[1], st_b[1]], axis=1),
              jnp.stack([st_f[2], st_b[2]], axis=1))
    return (h_f + flip(h_b)).astype(v.dtype), states


def prep_mixers(u, w_in_l, b_in_l, conv_w, a_log, dt_bias, f_bias):
    f32 = jnp.float32
    Bn, L, _ = u.shape
    split_at = [int(s) for s in np.cumsum(IN_SIZES)[:-1]]
    (aq, ak, av, bq, bk, bv, bg, ba, bb, cq, ck, cv, co, ci, cf) = jnp.split(
        jnp.einsum('bld,de->ble', u, w_in_l) + b_in_l, split_at, axis=-1)
    attn = (aq.reshape(Bn, L, A_HEADS, 2, A_QK_DIM), ak.reshape(Bn, L, A_HEADS, 2, A_QK_DIM),
            av.reshape(Bn, L, A_HEADS, A_V_DIM))
    qkv = jax.nn.silu(centred_dwconv(jnp.concatenate([bq, bk, bv], axis=-1), conv_w))
    dq, dk, dv = jnp.split(qkv, 3, axis=-1)
    beta = jax.nn.sigmoid(bb.astype(f32)).reshape(Bn, L, N_DIR, B_HEADS)
    g = -jnp.exp(a_log.astype(f32)) * jax.nn.softplus(ba.astype(f32).reshape(Bn, L, N_DIR, B_HEADS) + dt_bias.astype(f32))
    delta = (l2_norm(dq.reshape(Bn, L, B_HEADS, B_DIM)) * (B_DIM ** -0.5),
             l2_norm(dk.reshape(Bn, L, B_HEADS, B_DIM)), dv.reshape(Bn, L, B_HEADS, B_DIM), beta, g)
    ig = ci.astype(f32).reshape(Bn, L, N_DIR, C_HEADS)
    lf = jax.nn.log_sigmoid(cf.astype(f32).reshape(Bn, L, N_DIR, C_HEADS) + f_bias.astype(f32))
    mlstm = (cq.reshape(Bn, L, C_HEADS, C_DIM), ck.reshape(Bn, L, C_HEADS, C_DIM) * (C_DIM ** -0.5),
             cv.reshape(Bn, L, C_HEADS, C_DIM), ig, lf)
    return attn, delta, mlstm, bg, co


def merge_heads(a_out, o_delta, bg, h_m, co, attn_g, delta_g, mlstm_g, w_out_l, lam_init):
    Bn, L = a_out.shape[:2]
    a = rms_norm(a_out, attn_g) * (1.0 - lam_init)
    d = rms_norm(o_delta, delta_g) * jax.nn.silu(bg.reshape(Bn, L, B_HEADS, B_DIM))
    m = jax.nn.sigmoid(co.reshape(Bn, L, C_HEADS, C_DIM)) * rms_norm(h_m, mlstm_g)
    cat = jnp.concatenate([a.reshape(Bn, L, A_WIDTH), d.reshape(Bn, L, B_WIDTH), m.reshape(Bn, L, C_WIDTH)], axis=-1)
    return jnp.einsum('ble,ed->bld', cat, w_out_l)


def context_mixer(u, lp, lam_init):
    (w_in_l, b_in_l, w_out_l, lqk, attn_g, conv_w, a_log, dt_bias, delta_g, f_bias, mlstm_g) = lp
    (aq, ak, av), dl, ml, bg, co = prep_mixers(u, w_in_l, b_in_l, conv_w, a_log, dt_bias, f_bias)
    Bn = u.shape[0]
    f32 = jnp.float32
    a_out = diff_attention(aq, ak, av, diff_lambda(lqk, lam_init))
    o_d, s_d = delta_bidir(dl[0], dl[1], dl[2], dl[3], dl[4], jnp.zeros((Bn, N_DIR, B_HEADS, B_DIM, B_DIM), f32))
    h_m, (c_m, n_m, m_m) = mlstm_bidir(ml[0], ml[1], ml[2], ml[3], ml[4],
                                       jnp.zeros((Bn, N_DIR, C_HEADS, C_DIM, C_DIM), f32),
                                       jnp.zeros((Bn, N_DIR, C_HEADS, C_DIM), f32),
                                       jnp.zeros((Bn, N_DIR, C_HEADS), f32))
    out = merge_heads(a_out, o_d, bg, h_m, co, attn_g, delta_g, mlstm_g, w_out_l, lam_init)
    return out, ak, av, s_d, c_m, n_m, m_m


def latent_mixer(u, k_ctx, v_ctx, s_delta, c_st, n_st, m_st, lp, lam_init):
    (w_in_l, b_in_l, w_out_l, lqk, attn_g, conv_w, a_log, dt_bias, delta_g, f_bias, mlstm_g) = lp
    (aq, ak, av), dl, ml, bg, co = prep_mixers(u, w_in_l, b_in_l, conv_w, a_log, dt_bias, f_bias)
    k_all = jnp.concatenate([axial_rope(ak), k_ctx.astype(ak.dtype)], axis=1)
    v_all = jnp.concatenate([av, v_ctx.astype(av.dtype)], axis=1)
    a_out = diff_attention(axial_rope(aq), k_all, v_all, diff_lambda(lqk, lam_init))
    o_d, _ = delta_bidir(dl[0], dl[1], dl[2], dl[3], dl[4], s_delta)
    h_m, _ = mlstm_bidir(ml[0], ml[1], ml[2], ml[3], ml[4], c_st, n_st, m_st)
    return merge_heads(a_out, o_d, bg, h_m, co, attn_g, delta_g, mlstm_g, w_out_l, lam_init)


def setup_inputs(seed: int = 0) -> dict:
    key = jax.random.key(seed)
    ks = jax.random.split(key, 32)
    f32 = jnp.float32

    def nrm(k, shape, scale):
        return jax.random.normal(k, shape, f32) * scale

    dt = jnp.exp(jax.random.uniform(ks[21], (DEPTH, N_DIR, B_HEADS), f32, math.log(1e-3), math.log(1e-1)))
    return {
        'x_prompt': nrm(ks[0], (BATCH, SEQ, D_MODEL), 1.0),
        'x_sample': nrm(ks[1], (DEC_BATCH, DEC_SEQ, D_MODEL), 1.0),
        'cache_attn_k': nrm(ks[2], (DEC_BATCH, DEPTH, PAST_LEN, A_HEADS, 2, A_QK_DIM), 1.0),
        'cache_attn_v': nrm(ks[3], (DEC_BATCH, DEPTH, PAST_LEN, A_HEADS, A_V_DIM), 1.0),
        'state_delta': nrm(ks[4], (DEC_BATCH, DEPTH, N_DIR, B_HEADS, B_DIM, B_DIM), 0.3),
        'state_mlstm_C': nrm(ks[5], (DEC_BATCH, DEPTH, N_DIR, C_HEADS, C_DIM, C_DIM), 0.5),
        'state_mlstm_n': nrm(ks[6], (DEC_BATCH, DEPTH, N_DIR, C_HEADS, C_DIM), 0.5),
        'state_mlstm_m': nrm(ks[7], (DEC_BATCH, DEPTH, N_DIR, C_HEADS), 1.0),
        'c': nrm(ks[8], (DEC_BATCH, D_MODEL), 1.0),
        'c_ctx': nrm(ks[9], (D_MODEL,), 1.0),
        'norm1_g': 1.0 + nrm(ks[10], (DEPTH, D_MODEL), 0.05),
        'norm2_g': 1.0 + nrm(ks[11], (DEPTH, D_MODEL), 0.05),
        'w_mod': nrm(ks[12], (DEPTH, D_MODEL, 6 * D_MODEL), 0.5 * D_MODEL ** -0.5),
        'b_mod': nrm(ks[13], (DEPTH, 6 * D_MODEL), 0.02),
        'w_in': nrm(ks[14], (DEPTH, D_MODEL, IN_WIDTH), D_MODEL ** -0.5),
        'b_in': nrm(ks[15], (DEPTH, IN_WIDTH), 0.02),
        'w_out': nrm(ks[16], (DEPTH, MIX_WIDTH, D_MODEL), MIX_WIDTH ** -0.5),
        'lambda_qk': nrm(ks[17], (DEPTH, 4, A_QK_DIM), 0.1),
        'attn_subln_g': 1.0 + nrm(ks[18], (DEPTH, A_V_DIM), 0.05),
        'delta_conv_w': nrm(ks[19], (DEPTH, CONV_K, 3 * B_WIDTH), CONV_K ** -0.5),
        'delta_A_log': jnp.log(jax.random.uniform(ks[20], (DEPTH, N_DIR, B_HEADS), f32, 1.0, 16.0)),
        'delta_dt_bias': dt + jnp.log(-jnp.expm1(-dt)),
        'delta_norm_g': 1.0 + nrm(ks[22], (DEPTH, B_DIM), 0.05),
        'mlstm_f_bias': jax.random.uniform(ks[23], (DEPTH, N_DIR, C_HEADS), f32, 3.0, 6.0),
        'mlstm_norm_g': 1.0 + nrm(ks[24], (DEPTH, C_DIM), 0.05),
        'w_gate_up': nrm(ks[25], (DEPTH, D_MODEL, 2 * FFN_HIDDEN), D_MODEL ** -0.5),
        'w_down': nrm(ks[26], (DEPTH, FFN_HIDDEN, D_MODEL), FFN_HIDDEN ** -0.5),
        'final_norm_g': 1.0 + nrm(ks[27], (D_MODEL,), 0.05),
    }


def reference(x_prompt, x_sample, cache_attn_k, cache_attn_v, state_delta, state_mlstm_C, state_mlstm_n,
              state_mlstm_m, c, c_ctx, norm1_g, norm2_g, w_mod, b_mod, w_in, b_in, w_out, lambda_qk,
              attn_subln_g, delta_conv_w, delta_A_log, delta_dt_bias, delta_norm_g, mlstm_f_bias,
              mlstm_norm_g, w_gate_up, w_down, final_norm_g):
    xp, xs = x_prompt, x_sample
    sdt = x_prompt.dtype
    ks_l, vs_l, sd_l, cm_l, nm_l, mm_l = [], [], [], [], [], []
    for l in range(DEPTH):
        lp = (w_in[l], b_in[l], w_out[l], lambda_qk[l], attn_subln_g[l], delta_conv_w[l], delta_A_log[l],
              delta_dt_bias[l], delta_norm_g[l], mlstm_f_bias[l], mlstm_norm_g[l])
        lam_init = 0.8 - 0.6 * math.exp(-0.3 * l)
        sh1, sc1, g1, sh2, sc2, g2 = ada_mod(c_ctx, w_mod[l], b_mod[l])
        u = rms_norm(xp, norm1_g[l]) * (1.0 + sc1) + sh1
        mix, k_ctx, v_ctx, s_d, c_m, n_m, m_m = context_mixer(u, lp, lam_init)
        xp = xp + g1 * mix
        xp = xp + g2 * swiglu(rms_norm(xp, norm2_g[l]) * (1.0 + sc2) + sh2, w_gate_up[l], w_down[l])
        ks_l.append(k_ctx)
        vs_l.append(v_ctx)
        sd_l.append(s_d.astype(sdt))
        cm_l.append(c_m.astype(sdt))
        nm_l.append(n_m.astype(sdt))
        mm_l.append(m_m.astype(sdt))
        sh1, sc1, g1, sh2, sc2, g2 = ada_mod(c[:, None, :], w_mod[l], b_mod[l])
        u = rms_norm(xs, norm1_g[l]) * (1.0 + sc1) + sh1
        mix = latent_mixer(u, cache_attn_k[:, l], cache_attn_v[:, l], state_delta[:, l], state_mlstm_C[:, l],
                           state_mlstm_n[:, l], state_mlstm_m[:, l], lp, lam_init)
        xs = xs + g1 * mix
        xs = xs + g2 * swiglu(rms_norm(xs, norm2_g[l]) * (1.0 + sc2) + sh2, w_gate_up[l], w_down[l])
    y_prompt = rms_norm(xp, final_norm_g)
    y_sample = rms_norm(xs, final_norm_g)
    new_attn_k = jnp.stack(ks_l, axis=1)
    new_attn_v = jnp.stack(vs_l, axis=1)
    new_delta_S = jnp.stack(sd_l, axis=1)
    new_mlstm_C = jnp.stack(cm_l, axis=1)
    new_mlstm_n = jnp.stack(nm_l, axis=1)
    new_mlstm_m = jnp.stack(mm_l, axis=1)
    return (y_prompt, y_sample, new_attn_k, new_attn_v, new_delta_S, new_mlstm_C, new_mlstm_n, new_mlstm_m)
```

```cpp
#include <hip/hip_runtime.h>
#include <hip/hip_cooperative_groups.h>
#include <cstdio>
namespace cg = cooperative_groups;

typedef __attribute__((ext_vector_type(8))) short bf16x8;
typedef __attribute__((ext_vector_type(4))) short s16x4;
typedef __attribute__((ext_vector_type(4))) float f32x4;
typedef __attribute__((ext_vector_type(16))) float f32x16;
typedef unsigned short u16;

#define MFMA16(a, b, c) __builtin_amdgcn_mfma_f32_16x16x32_bf16((a), (b), (c), 0, 0, 0)
#define MFMA32(a, b, c) __builtin_amdgcn_mfma_f32_32x32x16_bf16((a), (b), (c), 0, 0, 0)

constexpr int DM = 1024;
constexpr int NT = 20480;
constexpr int NTC = 4096;
constexpr int INW = 3616;
constexpr int INP = 3712;
constexpr int FF = 2816;
constexpr float EPSF = 1e-6f;
constexpr float LOG2E = 1.4426950408889634f;
constexpr int LDS_CTL = 73728;
constexpr int LDS_BYTES = LDS_CTL + 16;
constexpr int XCD_BAR_WORDS_C = 3456;

constexpr size_t OFF_Q = 0;
constexpr size_t OFF_K = OFF_Q + (size_t)NT * 512 * 2;
constexpr size_t OFF_VT = OFF_K + (size_t)90112 * 128 * 2;
constexpr size_t OFF_BPRE = OFF_VT + (size_t)90112 * 128 * 2;
constexpr size_t OFF_BG = OFF_BPRE + (size_t)NT * 768 * 2;
constexpr size_t OFF_CQKV = OFF_BG + (size_t)NT * 256 * 2;
constexpr size_t OFF_CO = OFF_CQKV + (size_t)NT * 768 * 2;
constexpr size_t OFF_GATE = OFF_CO + (size_t)NT * 256 * 2;
constexpr size_t OFF_U = OFF_GATE + (size_t)NT * 32 * 4;
constexpr size_t OFF_P2 = OFF_U + (size_t)NT * 1024 * 2;
constexpr size_t OFF_MOM = OFF_P2 + (size_t)NT * 1024 * 2;
constexpr size_t OFF_SMALL = OFF_MOM + (size_t)NT * 512 * 2;
constexpr size_t OFF_MODV = OFF_SMALL;
constexpr size_t OFF_ROPE = OFF_MODV + 2 * 5 * 6144 * 4;
constexpr size_t OFF_LAM = OFF_ROPE + 1024 * 8;
constexpr size_t OFF_CNT = OFF_LAM + 64;
constexpr size_t OFF_DAUX = OFF_CNT + 64;
constexpr size_t OFF_MAUX = OFF_DAUX + (size_t)2560 * 128 * 4;
constexpr size_t OFF_BAR = OFF_MAUX + (size_t)2560 * 192 * 4;
constexpr size_t WS_NEED = OFF_BAR + (size_t)XCD_BAR_WORDS_C * 4;
constexpr size_t OFF_WIN = OFF_P2;
constexpr size_t OFF_WOUT = OFF_WIN + (size_t)INP * 1024 * 2;
constexpr size_t OFF_WGU = OFF_WOUT + (size_t)1024 * 1024 * 2;
constexpr size_t OFF_WDN = OFF_WGU + (size_t)2 * FF * 1024 * 2;
constexpr size_t OFF_DQKV = OFF_P2;
constexpr size_t OFF_MQK = OFF_P2 + (size_t)1280 * 3 * 4096 * 2;

constexpr size_t OUT_NK = (size_t)NT * 1024;
constexpr size_t OUT_NV = OUT_NK + 4194304;
constexpr size_t OUT_DS = OUT_NV + 4194304;
constexpr size_t OUT_MC = OUT_DS + 1048576;
constexpr size_t OUT_MN = OUT_MC + 1048576;
constexpr size_t OUT_MM = OUT_MN + 16384;

struct Params {
  const float* in[28];
  float* out;
  char* ws;
  int rep[4];
};
constexpr int REP0 = 1, REP1 = 1, REP2 = 1, REP3 = 1;

typedef __attribute__((ext_vector_type(2))) float f32x2_t;
typedef __attribute__((ext_vector_type(2))) __bf16 bf16x2_t;
__device__ __forceinline__ unsigned pack2(float a, float b) {
  f32x2_t v = {a, b};
  bf16x2_t h = __builtin_convertvector(v, bf16x2_t);
  return __builtin_bit_cast(unsigned, h);
}
__device__ __forceinline__ u16 f2bf(float f) { return (u16)(pack2(f, 0.f) & 0xffffu); }
__device__ __forceinline__ float bf2f(u16 h) { return __uint_as_float(((unsigned)h) << 16); }
__device__ __forceinline__ float siluf(float x) { return x * __builtin_amdgcn_rcpf(1.f + __expf(-x)); }
__device__ __forceinline__ float sigmf(float x) { return __builtin_amdgcn_rcpf(1.f + __expf(-x)); }
__device__ __forceinline__ float softplusf(float x) { return fmaxf(x, 0.f) + log1pf(__expf(-fabsf(x))); }
__device__ __forceinline__ float shx(float v, int o, int lane) {
  return __int_as_float(__builtin_amdgcn_ds_bpermute((lane ^ o) << 2, __float_as_int(v)));
}
__device__ __forceinline__ float shl_(float v, int src) {
  return __int_as_float(__builtin_amdgcn_ds_bpermute(src << 2, __float_as_int(v)));
}
__device__ __forceinline__ float wave_sum(float v, int lane) {
#pragma unroll
  for (int o = 32; o > 0; o >>= 1) v += shx(v, o, lane);
  return v;
}
__device__ __forceinline__ void glds16(const void* g, void* l) {
  __builtin_amdgcn_global_load_lds((const unsigned*)g, (__attribute__((address_space(3))) unsigned*)l, 16, 0, 0);
}
__device__ __forceinline__ int otid() { int t = threadIdx.x; asm volatile("" : "+v"(t)); return t; }
#define LAUNDER(q, p) const Params& q = (p);
__device__ __forceinline__ void wait_vm0() { asm volatile("s_waitcnt vmcnt(0)" ::: "memory"); }


#define XB_TMO      128
#define XB_XCNT(j)  (256  + 64 * (j))
#define XB_XSUB(j)  (1280 + 64 * (j))
#define XB_XGEN(j)  (2304 + 64 * (j))
#define XB_TOP      3328
#define XB_TOPGEN   3392
#define XCD_BAR_WORDS 3456
#define XB_SPIN_CAP (1u << 20)
#define LAS __attribute__((address_space(3)))
__device__ __forceinline__ unsigned xb_ld(unsigned* p)              { return __hip_atomic_load(p, __ATOMIC_RELAXED, __HIP_MEMORY_SCOPE_AGENT); }
__device__ __forceinline__ unsigned xb_add(unsigned* p, unsigned v) { return __hip_atomic_fetch_add(p, v, __ATOMIC_RELAXED, __HIP_MEMORY_SCOPE_AGENT); }
__device__ __forceinline__ unsigned xb_xcc_id() { return (unsigned)__builtin_amdgcn_s_getreg((3 << 11) | 20) & 0xFu; }
#define XB_SPIN(cond, bar) do { unsigned _sp = 0; while (cond) { __builtin_amdgcn_s_sleep(1); \
    if ((++_sp & 255u) == 0u) { if (xb_ld(&(bar)[XB_TMO])) break; if (_sp > XB_SPIN_CAP) { atomicAdd(&(bar)[XB_TMO], 1u); break; } } } } while (0)
struct XcdBarrier { unsigned* bar; unsigned x; volatile LAS unsigned* st; };
__device__ __forceinline__ XcdBarrier xcd_barrier_post(unsigned* bar, volatile LAS unsigned* st) {
  XcdBarrier b; b.bar = bar; b.x = xb_xcc_id(); b.st = st;
  if (threadIdx.x == 0) (void)xb_add(&bar[XB_XCNT(b.x)], 1u);
  return b;
}
__device__ __forceinline__ void xcd_barrier_complete(unsigned* bar, unsigned x, unsigned& nloc, unsigned& nx) {
  const unsigned G = gridDim.x * gridDim.y * gridDim.z;
  unsigned sum, cnt, mine, sp = 0u;
  for (;;) {
    sum = 0u; cnt = 0u; mine = 0u;
#pragma unroll
    for (unsigned j = 0; j < 16; ++j) { const unsigned c = xb_ld(&bar[XB_XCNT(j)]); sum += c; cnt += (c > 0u) ? 1u : 0u; mine = (j == x) ? c : mine; }
    if (sum == G) break;
    __builtin_amdgcn_s_sleep(1);
    if ((++sp & 255u) == 0u) { if (xb_ld(&bar[XB_TMO])) break; if (sp > XB_SPIN_CAP) { atomicAdd(&bar[XB_TMO], 1u); break; } }
  }
  nloc = mine > 0u ? mine : 1u; nx = cnt > 0u ? cnt : 1u;
}
__device__ __forceinline__ void xcd_barrier(const XcdBarrier& b) {
  asm volatile("s_waitcnt vmcnt(0)" ::: "memory");
  __syncthreads();
  if (threadIdx.x == 0) {
    unsigned* bar = b.bar;
    __builtin_amdgcn_s_waitcnt(0);
    unsigned nloc = b.st[0], nx = b.st[1];
    if (nloc == 0u) { xcd_barrier_complete(bar, b.x, nloc, nx); b.st[0] = nloc; b.st[1] = nx; }
    const unsigned old = xb_add(&bar[XB_XSUB(b.x)], 1u);
    const unsigned gen = old / nloc;
    if (old + 1u == (gen + 1u) * nloc) {
      __builtin_amdgcn_fence(__ATOMIC_RELEASE, "agent");
      asm volatile("s_waitcnt vmcnt(0)" ::: "memory");
      const unsigned og = xb_add(&bar[XB_TOP], 1u);
      const unsigned tg = og / nx;
      if (og + 1u == (tg + 1u) * nx) xb_add(&bar[XB_TOPGEN], 1u);
      else XB_SPIN(xb_ld(&bar[XB_TOPGEN]) == tg, bar);
      __builtin_amdgcn_fence(__ATOMIC_ACQUIRE, "agent");
      xb_add(&bar[XB_XGEN(b.x)], 1u);
      asm volatile("s_waitcnt vmcnt(0)" ::: "memory");
    } else {
      XB_SPIN(xb_ld(&bar[XB_XGEN(b.x)]) == gen, bar);
      __builtin_amdgcn_fence(__ATOMIC_ACQUIRE, "agent");
      asm volatile("s_waitcnt vmcnt(0)" ::: "memory");
    }
  }
  __syncthreads();
}

__device__ __forceinline__ int tok_seq(int t) { return t < NTC ? (t >> 8) : 16 + ((t - NTC) >> 12); }
__device__ __forceinline__ int seq_tok0(int s) { return s < 16 ? s * 256 : NTC + (s - 16) * 4096; }
__device__ __forceinline__ int seq_len(int s) { return s < 16 ? 256 : 4096; }
__device__ __forceinline__ int seq_lk(int s) { return s < 16 ? 256 : 4608; }
__device__ __forceinline__ int seq_mv(int s) { return s < 16 ? 0 : s - 15; }
__device__ __forceinline__ size_t krow0(int s, int h) {
  return s < 16 ? (size_t)(s * 4 + h) * 256 : (size_t)16384 + (size_t)((s - 16) * 4 + h) * 4608;
}
__device__ __forceinline__ const float* xrow_ptr(const Params& p, int l, int t) {
  if (l == 0) return t < NTC ? p.in[0] + (size_t)t * DM : p.in[1] + (size_t)(t - NTC) * DM;
  return p.out + (size_t)t * DM;
}
__device__ __forceinline__ int in_src_col(int n) {
  if (n < 2560) return n;
  if (n < 3584) return n + 16;
  if (n < 3600) return n - 3584 + 2560;
  if (n < 3616) return n;
  return -1;
}

__device__ void wconv_tile(const float* W, int K, int N, u16* Wt, int mode, int kt, int nt, char* smem) {
  float* tile = (float*)smem;
  const int tid = otid();
  __syncthreads();
  for (int e = tid; e < 1024; e += 256) {
    int kk = e >> 4, nn = (e & 15) * 4;
    int nd = nt * 64 + nn;
    int src;
    if (mode == 0) src = nd;
    else if (mode == 1) src = in_src_col(nd);
    else { int t128 = nd >> 7, w = nd & 127; int pp = w >> 5, half = (w >> 4) & 1, r = w & 15; src = half * FF + t128 * 64 + pp * 16 + r; }
    float4 v = make_float4(0.f, 0.f, 0.f, 0.f);
    if (src >= 0) v = *(const float4*)(W + (size_t)(kt * 64 + kk) * N + src);
    float* d = tile + kk * 65 + nn;
    d[0] = v.x; d[1] = v.y; d[2] = v.z; d[3] = v.w;
  }
  __syncthreads();
  for (int e = tid; e < 2048; e += 256) {
    int nn = e >> 5, k2 = (e & 31) * 2;
    unsigned v = pack2(tile[k2 * 65 + nn], tile[(k2 + 1) * 65 + nn]);
    *(unsigned*)(Wt + (size_t)(nt * 64 + nn) * K + kt * 64 + k2) = v;
  }
}

__device__ void wconv_job(const float* W, u16* Wt, int K, int N, int Np, int mode, char* smem, int bid, int nb) {
  int nkt = K / 64, nnt = Np / 64;
  for (int t = bid; t < nkt * nnt; t += nb) wconv_tile(W, K, N, Wt, mode, t / nnt, t % nnt, smem);
}

__device__ void mod_task(const Params& p, int task, char* smem) {
  float* sc = (float*)smem;
  float* red = sc + 5 * 1024;
  const int tid = otid();
  __syncthreads();
  for (int e = tid; e < 5 * 1024; e += 256) {
    int mv = e >> 10, k = e & 1023;
    float c = mv == 0 ? p.in[9][k] : p.in[8][(mv - 1) * 1024 + k];
    sc[e] = siluf(c);
  }
  __syncthreads();
  int l = task / 96, cg0 = (task % 96) * 64;
  int quad = tid & 15, kg = tid >> 4;
  const float* W = p.in[12] + (size_t)l * 1024 * 6144 + cg0 + quad * 4;
  float acc[5][4];
#pragma unroll
  for (int a = 0; a < 5; ++a)
#pragma unroll
    for (int b = 0; b < 4; ++b) acc[a][b] = 0.f;
  for (int kk = 0; kk < 64; ++kk) {
    int k = kg * 64 + kk;
    float4 w = *(const float4*)(W + (size_t)k * 6144);
#pragma unroll
    for (int a = 0; a < 5; ++a) {
      float s = sc[a * 1024 + k];
      acc[a][0] += s * w.x; acc[a][1] += s * w.y; acc[a][2] += s * w.z; acc[a][3] += s * w.w;
    }
  }
#pragma unroll
  for (int a = 0; a < 5; ++a)
#pragma unroll
    for (int b = 0; b < 4; ++b) red[(kg * 5 + a) * 64 + quad * 4 + b] = acc[a][b];
  __syncthreads();
  float* modv = (float*)(p.ws + OFF_MODV);
  for (int e = tid; e < 320; e += 256) {
    int a = e >> 6, c = e & 63;
    float s = p.in[13][l * 6144 + cg0 + c];
    for (int g = 0; g < 16; ++g) s += red[(g * 5 + a) * 64 + c];
    modv[(size_t)(l * 5 + a) * 6144 + cg0 + c] = s;
  }
}

__device__ void misc_task(const Params& p) {
  const int tid = otid();
  float2* rope = (float2*)(p.ws + OFF_ROPE);
  for (int e = tid; e < 1024; e += 256) {
    int pos = e >> 4, f = e & 15;
    float inv = powf(10000.f, -(float)f / 16.f);
    float ang = (float)pos * inv;
    rope[e] = make_float2(cosf(ang), sinf(ang));
  }
  if (tid < 2) {
    const float* lq = p.in[17] + tid * 256;
    float s1 = 0.f, s2 = 0.f;
    for (int i = 0; i < 64; ++i) { s1 += lq[i] * lq[64 + i]; s2 += lq[128 + i] * lq[192 + i]; }
    float lam_init = 0.8f - 0.6f * expf(-0.3f * (float)tid);
    ((float*)(p.ws + OFF_LAM))[tid] = expf(s1) - expf(s2) + lam_init;
  }
  if (tid < 16) ((unsigned*)(p.ws + OFF_CNT))[tid] = 0u;
}

__device__ void norm_phase(const Params& p, int l, int which, int bid, int nb) {
  const int tid_ = otid();
  const int wave = tid_ >> 6, lane = tid_ & 63;
  const float* g = p.in[which == 0 ? 10 : 11] + l * 1024;
  const float* modv = (const float*)(p.ws + OFF_MODV);
  u16* U = (u16*)(p.ws + OFF_U);
  for (int t = bid * 4 + wave; t < NT; t += nb * 4) {
    const float* x = xrow_ptr(p, which == 0 ? l : 1, t);
    int mv = seq_mv(tok_seq(t));
    const float* sh = modv + (size_t)(l * 5 + mv) * 6144 + (which == 0 ? 0 : 3) * 1024;
    const float* sc = sh + 1024;
    float4 v[4];
    float ss = 0.f;
#pragma unroll
    for (int i = 0; i < 4; ++i) {
      v[i] = *(const float4*)(x + i * 256 + lane * 4);
      ss += v[i].x * v[i].x + v[i].y * v[i].y + v[i].z * v[i].z + v[i].w * v[i].w;
    }
    ss = wave_sum(ss, lane);
    float rs = rsqrtf(ss * (1.f / 1024.f) + EPSF);
#pragma unroll
    for (int i = 0; i < 4; ++i) {
      int c = i * 256 + lane * 4;
      float4 gg = *(const float4*)(g + c), s4 = *(const float4*)(sc + c), h4 = *(const float4*)(sh + c);
      float a0 = v[i].x * rs * gg.x * (1.f + s4.x) + h4.x;
      float a1 = v[i].y * rs * gg.y * (1.f + s4.y) + h4.y;
      float a2 = v[i].z * rs * gg.z * (1.f + s4.z) + h4.z;
      float a3 = v[i].w * rs * gg.w * (1.f + s4.w) + h4.w;
      uint2 o; o.x = pack2(a0, a1); o.y = pack2(a2, a3);
      *(uint2*)(U + (size_t)t * 1024 + c) = o;
    }
  }
}

__device__ void cache_conv(const Params& p, int l, char* smem, int bid, int nb) {
  u16* K = (u16*)(p.ws + OFF_K);
  u16* VT = (u16*)(p.ws + OFF_VT);
  const int tid_ = otid();
  for (int e = bid * 256 + tid_; e < 262144; e += nb * 256) {
    int c4 = (e & 31) * 4, h = (e >> 5) & 3, pt = (e >> 7) & 511, b = e >> 16;
    float4 v = *(const float4*)(p.in[2] + ((size_t)((b * 2 + l) * 512 + pt) * 4 + h) * 128 + c4);
    uint2 o; o.x = pack2(v.x, v.y); o.y = pack2(v.z, v.w);
    *(uint2*)(K + (krow0(16 + b, h) + 4096 + pt) * 128 + c4) = o;
  }
  u16* T = (u16*)smem;
  for (int tile = bid; tile < 128; tile += nb) {
    int pt0 = (tile & 7) * 64, h = (tile >> 3) & 3, b = tile >> 5;
    __syncthreads();
    for (int e = tid_; e < 2048; e += 256) {
      int pt = e >> 5, c4 = (e & 31) * 4;
      float4 v = *(const float4*)(p.in[3] + ((size_t)((b * 2 + l) * 512 + pt0 + pt) * 4 + h) * 128 + c4);
      const int a4 = (pt >> 2) & 3;
      const int pp = (pt & ~15) | ((((a4 & 1) << 1) | (a4 >> 1)) << 2) | (pt & 3);
      T[(c4 + 0) * 72 + pp] = f2bf(v.x); T[(c4 + 1) * 72 + pp] = f2bf(v.y);
      T[(c4 + 2) * 72 + pp] = f2bf(v.z); T[(c4 + 3) * 72 + pp] = f2bf(v.w);
    }
    __syncthreads();
    for (int e = tid_; e < 1024; e += 256) {
      int c = e >> 3, ch = e & 7;
      uint4 v = *(const uint4*)(T + c * 72 + ch * 8);
      *(uint4*)(VT + krow0(16 + b, h) * 128 + (size_t)c * 4608 + 4096 + pt0 + ch * 8) = v;
    }
  }
}

enum { EPI_IN = 0, EPI_RES1 = 1, EPI_SWIGLU = 2, EPI_RES2 = 3 };

template <int EPI>
__device__ __forceinline__ void gemm_epilogue(const Params& p, int l, int rowbase, int nt, f32x4 (&acc)[4][4]) {
  const int tid_ = otid();
  const int lane = tid_ & 63, wave = tid_ >> 6;
  const int wn = wave & 1, r = lane & 15, q = lane >> 4;
  const int m0 = rowbase;
  const int seq = tok_seq(m0);
  const int mv = seq_mv(seq);
  const float* modv = (const float*)(p.ws + OFF_MODV) + (size_t)(l * 5 + mv) * 6144;
  if (EPI == EPI_RES1 || EPI == EPI_RES2) {
    const float* gate = modv + (EPI == EPI_RES1 ? 2 : 5) * 1024;
#pragma unroll
    for (int ms = 0; ms < 4; ++ms) {
      const int t = m0 + ms * 16 + r;
      const float* xr = (EPI == EPI_RES1) ? xrow_ptr(p, l, t) : p.out + (size_t)t * DM;
      float* xo = p.out + (size_t)t * DM;
#pragma unroll
      for (int ns = 0; ns < 4; ++ns) {
        const int col = nt * 128 + wn * 64 + ns * 16 + 4 * q;
        const float4 g4 = *(const float4*)(gate + col);
        const float4 x4 = *(const float4*)(xr + col);
        float4 o;
        o.x = x4.x + g4.x * acc[ms][ns][0]; o.y = x4.y + g4.y * acc[ms][ns][1];
        o.z = x4.z + g4.z * acc[ms][ns][2]; o.w = x4.w + g4.w * acc[ms][ns][3];
        *(float4*)(xo + col) = o;
      }
    }
  } else if (EPI == EPI_SWIGLU) {
    u16* H = (u16*)(p.ws);
#pragma unroll
    for (int ms = 0; ms < 4; ++ms) {
      const int t = m0 + ms * 16 + r;
#pragma unroll
      for (int pp = 0; pp < 2; ++pp) {
        const int col = nt * 64 + (wn * 2 + pp) * 16 + 4 * q;
        float hv[4];
#pragma unroll
        for (int i = 0; i < 4; ++i) hv[i] = siluf(acc[ms][2 * pp][i]) * acc[ms][2 * pp + 1][i];
        uint2 o; o.x = pack2(hv[0], hv[1]); o.y = pack2(hv[2], hv[3]);
        *(uint2*)(H + (size_t)t * FF + col) = o;
      }
    }
  } else {
    const bool latent = seq >= 16;
    const int tok0 = seq_tok0(seq);
    const float* bias = p.in[15] + l * INW;
    const float2* rope = (const float2*)(p.ws + OFF_ROPE);
#pragma unroll
    for (int ms = 0; ms < 4; ++ms)
#pragma unroll
      for (int ns = 0; ns < 4; ++ns) {
        int c = wn * 64 + ns * 16 + r;
        int ncol = nt * 128 + c;
        int sc = in_src_col(ncol);
        float bv = sc >= 0 ? bias[sc] : 0.f;
        float v[4];
#pragma unroll
        for (int i = 0; i < 4; ++i) v[i] = acc[ms][ns][i] + bv;
        int tb = m0 + ms * 16 + 4 * q;
        if (nt < 8) {
          int head = nt & 3;
          if (latent) {
            int d = c & 63, pi = d >> 1;
#pragma unroll
            for (int i = 0; i < 4; ++i) {
              float other = shx(v[i], 1, lane);
              int tl = tb + i - tok0;
              int pos = pi < 16 ? (tl >> 6) : (tl & 63);
              float2 cs = rope[pos * 16 + (pi & 15)];
              v[i] = (d & 1) ? (other * cs.y + v[i] * cs.x) : (v[i] * cs.x - other * cs.y);
            }
          }
          if (nt < 4) {
            u16* Q = (u16*)(p.ws + OFF_Q);
#pragma unroll
            for (int i = 0; i < 4; ++i) Q[(size_t)(tb + i) * 512 + head * 128 + c] = f2bf(v[i] * (0.125f * LOG2E));
          } else {
            u16* K = (u16*)(p.ws + OFF_K);
            size_t kr = krow0(seq, head) + (tb - tok0);
#pragma unroll
            for (int i = 0; i < 4; ++i) K[(kr + i) * 128 + c] = f2bf(v[i]);
            if (!latent) {
#pragma unroll
              for (int i = 0; i < 4; ++i)
                p.out[OUT_NK + ((size_t)((seq * 2 + l) * 256 + (tb + i - tok0)) * 4 + head) * 128 + c] = v[i];
            }
          }
        } else if (nt < 12) {
          int head = nt - 8;
          u16* VT = (u16*)(p.ws + OFF_VT);
          uint2 o; o.x = pack2(v[0], v[1]); o.y = pack2(v[2], v[3]);
          const int tl0 = tb - tok0;
          const int a4 = (tl0 >> 2) & 3;
          const int tperm = (tl0 & ~15) | ((((a4 & 1) << 1) | (a4 >> 1)) << 2);
          *(uint2*)(VT + krow0(seq, head) * 128 + (size_t)c * seq_lk(seq) + tperm) = o;
          if (!latent) {
#pragma unroll
            for (int i = 0; i < 4; ++i)
              p.out[OUT_NV + ((size_t)((seq * 2 + l) * 256 + (tb + i - tok0)) * 4 + head) * 128 + c] = v[i];
          }
        } else if (nt < 18) {
          u16* B = (u16*)(p.ws + OFF_BPRE);
#pragma unroll
          for (int i = 0; i < 4; ++i) B[(size_t)(tb + i) * 768 + (nt - 12) * 128 + c] = f2bf(v[i]);
        } else if (nt < 20) {
          u16* B = (u16*)(p.ws + OFF_BG);
#pragma unroll
          for (int i = 0; i < 4; ++i) B[(size_t)(tb + i) * 256 + (nt - 18) * 128 + c] = f2bf(v[i]);
        } else if (nt < 26) {
          u16* B = (u16*)(p.ws + OFF_CQKV);
          float s = (nt == 22 || nt == 23) ? 0.125f : 1.f;
#pragma unroll
          for (int i = 0; i < 4; ++i) B[(size_t)(tb + i) * 768 + (nt - 20) * 128 + c] = f2bf(v[i] * s);
        } else if (nt < 28) {
          u16* B = (u16*)(p.ws + OFF_CO);
#pragma unroll
          for (int i = 0; i < 4; ++i) B[(size_t)(tb + i) * 256 + (nt - 26) * 128 + c] = f2bf(v[i]);
        } else {
          if (c < 32) {
            float* G = (float*)(p.ws + OFF_GATE);
#pragma unroll
            for (int i = 0; i < 4; ++i) G[(size_t)(tb + i) * 32 + c] = v[i];
          }
        }
      }
  }
}

template <int EPI>
__device__ void gemm_tile(const Params& p, int l, const u16* A0, int lda0, const u16* A1, int lda1, int ksplit,
                          const u16* Bt, int K, int mt, int nt, char* smem) {
  const int tid = otid(), lane = tid & 63, wave = tid >> 6;
  const int wm = wave >> 1, wn = wave & 1, r = lane & 15, q = lane >> 4;
  const int nk = K / 64;
  f32x4 acc[4][4];
#pragma unroll
  for (int a = 0; a < 4; ++a)
#pragma unroll
    for (int b = 0; b < 4; ++b) acc[a][b] = (f32x4){0.f, 0.f, 0.f, 0.f};

  const int srow = wave * 8 + (lane >> 3);
  const unsigned kcb = (unsigned)(((lane & 7) ^ ((srow >> 1) & 7)) * 16);
  const unsigned ldst0 = (unsigned)(wave * 1024 + lane * 16);
  auto issue = [&](int kt, int buf) {
    char* sA = smem + buf * 32768 + ldst0;
    char* sB = sA + 16384;
    const int k0 = kt * 64;
    const char* Ab; unsigned lda2; unsigned ka;
    if (k0 < ksplit) { Ab = (const char*)(A0 + (size_t)mt * 128 * lda0); lda2 = (unsigned)lda0 * 2; ka = (unsigned)k0 * 2; }
    else { Ab = (const char*)(A1 + (size_t)mt * 128 * lda1); lda2 = (unsigned)lda1 * 2; ka = (unsigned)(k0 - ksplit) * 2; }
    const char* Bb = (const char*)(Bt + (size_t)nt * 128 * K);
    const unsigned ao = (unsigned)srow * lda2 + kcb + ka, bo = (unsigned)srow * (unsigned)(K * 2) + kcb + (unsigned)k0 * 2;
#pragma unroll
    for (int i = 0; i < 4; ++i) {
      glds16(Ab + (ao + (unsigned)i * 32u * lda2), sA + i * 4096);
      glds16(Bb + (bo + (unsigned)i * 32u * (unsigned)(K * 2)), sB + i * 4096);
    }
  };
  __syncthreads();
  issue(0, 0);
  for (int kt = 0; kt < nk; ++kt) {
    wait_vm0();
    __syncthreads();
    if (kt + 1 < nk) issue(kt + 1, (kt + 1) & 1);
    const char* sA = smem + (kt & 1) * 32768;
    const char* sB = sA + 16384;
    __builtin_amdgcn_iglp_opt(0);
#pragma unroll
    for (int s = 0; s < 2; ++s) {
      bf16x8 af[4], bfr[4];
#pragma unroll
      for (int ms = 0; ms < 4; ++ms) {
        int row = wm * 64 + ms * 16 + r;
        af[ms] = *(const bf16x8*)(sA + row * 128 + (((s * 4 + q) ^ ((row >> 1) & 7)) * 16));
      }
#pragma unroll
      for (int ns = 0; ns < 4; ++ns) {
        int row = wn * 64 + ns * 16 + r;
        bfr[ns] = *(const bf16x8*)(sB + row * 128 + (((s * 4 + q) ^ ((row >> 1) & 7)) * 16));
      }
#pragma unroll
      for (int ms = 0; ms < 4; ++ms)
#pragma unroll
        for (int ns = 0; ns < 4; ++ns)
          acc[ms][ns] = (EPI == EPI_IN) ? MFMA16(af[ms], bfr[ns], acc[ms][ns]) : MFMA16(bfr[ns], af[ms], acc[ms][ns]);
    }
  }
  gemm_epilogue<EPI>(p, l, mt * 128 + wm * 64, nt, acc);
}


__device__ __forceinline__ bool tile_map(int bid, int nb, int it, int ntm, int ntn, int& m, int& n) {
  if (nb != 512 || (ntm & 7)) {
    int t = bid + it * nb;
    if (t >= ntm * ntn) return false;
    m = t % ntm; n = t / ntm;
    return true;
  }
  const int x = bid & 7, j = bid >> 3, MX = ntm >> 3;
  int u = it * 64 + j;
  const int fullp = ntn >> 2;
  int np, wp;
  if (u < fullp * 4 * MX) { np = u / (4 * MX); u -= np * 4 * MX; wp = 4; }
  else { np = fullp; u -= fullp * 4 * MX; wp = ntn & 3; if (u >= wp * MX) return false; }
  m = x * MX + u / wp;
  n = np * 4 + u % wp;
  return true;
}

template <int EPI>
__device__ void gemm_phase(const Params& p, int l, const u16* A0, int lda0, const u16* A1, int lda1, int ksplit,
                           const u16* Bt, int K, int ntn, char* smem, int bid, int nb) {
  const int ntm = NT / 128;
  int m, n;
  for (int it = 0; tile_map(bid, nb, it, ntm, ntn, m, n); ++it) gemm_tile<EPI>(p, l, A0, lda0, A1, lda1, ksplit, Bt, K, m, n, smem);
}


template <int EPI>
__device__ void gemm_tile_big(const Params& p, int l, const u16* A, int lda, const u16* Bt, int K, int mt, int nt, char* smem) {
  const int tid = otid(), lane = tid & 63, wave = tid >> 6;
  const int wm = wave >> 1, wn = wave & 1, r = lane & 15, q = lane >> 4;
  const int nk = K / 32;
  f32x4 acc[2][4][4];
#pragma unroll
  for (int hf = 0; hf < 2; ++hf)
#pragma unroll
    for (int a = 0; a < 4; ++a)
#pragma unroll
      for (int b = 0; b < 4; ++b) acc[hf][a][b] = (f32x4){0.f, 0.f, 0.f, 0.f};
  const int srow = wave * 16 + (lane >> 2);
  const unsigned kcb = (unsigned)(((lane & 3) ^ ((srow >> 2) & 3)) * 16);
  const unsigned ldst0 = (unsigned)(wave * 1024 + lane * 16);
  const char* Ab = (const char*)(A + (size_t)mt * 256 * lda);
  const char* Bb = (const char*)(Bt + (size_t)nt * 128 * K);
  const unsigned lda2 = (unsigned)lda * 2, ldb2 = (unsigned)K * 2;
  auto issue = [&](int kt, int buf) {
    char* sA = smem + buf * 24576 + ldst0;
    char* sB = sA + 16384;
    const unsigned ao = (unsigned)srow * lda2 + kcb + (unsigned)kt * 64u, bo = (unsigned)srow * ldb2 + kcb + (unsigned)kt * 64u;
#pragma unroll
    for (int i = 0; i < 4; ++i) glds16(Ab + (ao + (unsigned)i * 64u * lda2), sA + i * 4096);
#pragma unroll
    for (int i = 0; i < 2; ++i) glds16(Bb + (bo + (unsigned)i * 64u * ldb2), sB + i * 4096);
  };
  __syncthreads();
  issue(0, 0);
  issue(1, 1);
  int stg = 0;
  for (int kt = 0; kt < nk; ++kt) {
    if (kt + 1 < nk) asm volatile("s_waitcnt vmcnt(6)" ::: "memory");
    else asm volatile("s_waitcnt vmcnt(0)" ::: "memory");
    __builtin_amdgcn_s_barrier();
    if (kt + 2 < nk) issue(kt + 2, stg >= 1 ? stg - 1 : 2);
    const unsigned bo = (unsigned)stg * 24576u;
    stg = stg == 2 ? 0 : stg + 1;
    __builtin_amdgcn_iglp_opt(0);
    bf16x8 bfr[4];
#pragma unroll
    for (int ns = 0; ns < 4; ++ns) {
      int row = wn * 64 + ns * 16 + r;
      bfr[ns] = *(const bf16x8*)(smem + bo + 16384u + (unsigned)row * 64u + (unsigned)((q ^ ((row >> 2) & 3)) * 16));
    }
#pragma unroll
    for (int hf = 0; hf < 2; ++hf) {
      bf16x8 af[4];
#pragma unroll
      for (int ms = 0; ms < 4; ++ms) {
        int row = wm * 128 + hf * 64 + ms * 16 + r;
        af[ms] = *(const bf16x8*)(smem + bo + (unsigned)row * 64u + (unsigned)((q ^ ((row >> 2) & 3)) * 16));
      }
#pragma unroll
      for (int ms = 0; ms < 4; ++ms)
#pragma unroll
        for (int ns = 0; ns < 4; ++ns) acc[hf][ms][ns] = MFMA16(bfr[ns], af[ms], acc[hf][ms][ns]);
    }
  }
  gemm_epilogue<EPI>(p, l, mt * 256 + wm * 128, nt, acc[0]);
  gemm_epilogue<EPI>(p, l, mt * 256 + wm * 128 + 64, nt, acc[1]);
}

template <int EPI>
__device__ void gemm_phase_big(const Params& p, int l, const u16* A, int lda, const u16* Bt, int K, int ntn, char* smem, int bid, int nb) {
  const int ntm = NT / 256;
  int m, n;
  for (int it = 0; tile_map(bid, nb, it, ntm, ntn, m, n); ++it) gemm_tile_big<EPI>(p, l, A, lda, Bt, K, m, n, smem);
}

__device__ void prep_item(const Params& p, int l, int ci, int h, char* smem) {
  const int tid = otid(), lane = tid & 63, wave = tid >> 6;
  float* qs = (float*)smem;
  float* ks = qs + 64 * 65;
  float* As = (float*)smem;
  float* gcs = (float*)(smem + 33280);
  float* bes = gcs + 128;
  const int t0 = ci * 64;
  const int seq = tok_seq(t0);
  const int stok0 = seq_tok0(seq), slen = seq_len(seq);
  const int ti = tid >> 4, tj = tid & 15;
  const int item = ci * 4 + h;
  __syncthreads();
  {
    const u16* C = (const u16*)(p.ws + OFF_CQKV);
    for (int e = tid; e < 1024; e += 256) {
      int t = (e >> 3) & 63, ch = e & 7, isk = e >> 9;
      uint4 v = *(const uint4*)(C + (size_t)(t0 + t) * 768 + isk * 256 + h * 64 + ch * 8);
      float* dst = (isk ? ks : qs) + t * 65 + ch * 8;
      dst[0] = bf2f(v.x & 0xffff); dst[1] = bf2f(v.x >> 16); dst[2] = bf2f(v.y & 0xffff); dst[3] = bf2f(v.y >> 16);
      dst[4] = bf2f(v.z & 0xffff); dst[5] = bf2f(v.z >> 16); dst[6] = bf2f(v.w & 0xffff); dst[7] = bf2f(v.w >> 16);
    }
    if (wave < 2) {
      const int dir = wave, i = lane;
      const int t = t0 + (dir ? 63 - i : i);
      const float* G = (const float*)(p.ws + OFF_GATE) + (size_t)t * 32 + dir * 4 + h;
      float ba = G[0], bb = G[8], ig = G[16], cf = G[24] + p.in[23][l * 8 + dir * 4 + h];
      float lf = fminf(cf, 0.f) - log1pf(__expf(-fabsf(cf)));
      float g = -__expf(p.in[20][l * 8 + dir * 4 + h]) * softplusf(ba + p.in[21][l * 8 + dir * 4 + h]);
      float be = sigmf(bb);
      float b = lf, gc = g;
#pragma unroll
      for (int o = 1; o < 64; o <<= 1) {
        float tb = shl_(b, (lane - o) & 63), tg = shl_(gc, (lane - o) & 63);
        if (lane >= o) { b += tb; gc += tg; }
      }
      float a = ig - b, pm = a;
#pragma unroll
      for (int o = 1; o < 64; o <<= 1) {
        float tp = shl_(pm, (lane - o) & 63);
        if (lane >= o) pm = fmaxf(pm, tp);
      }
      float* maux = (float*)(p.ws + OFF_MAUX) + (size_t)(item * 2 + dir) * 192;
      maux[i] = b; maux[64 + i] = a; maux[128 + i] = pm;
      float* daux = (float*)(p.ws + OFF_DAUX) + (size_t)(item * 2 + dir) * 128;
      daux[i] = gc; daux[64 + i] = be;
      gcs[dir * 64 + i] = gc; bes[dir * 64 + i] = be;
    }
    __syncthreads();
    float acc[4][4];
#pragma unroll
    for (int a = 0; a < 4; ++a)
#pragma unroll
      for (int b = 0; b < 4; ++b) acc[a][b] = 0.f;
    for (int d = 0; d < 64; ++d) {
      float x[4], y[4];
#pragma unroll
      for (int a = 0; a < 4; ++a) { x[a] = qs[(4 * ti + a) * 65 + d]; y[a] = ks[(4 * tj + a) * 65 + d]; }
#pragma unroll
      for (int a = 0; a < 4; ++a)
#pragma unroll
        for (int b = 0; b < 4; ++b) acc[a][b] += x[a] * y[b];
    }
    u16* MQK = (u16*)(p.ws + OFF_MQK) + (size_t)item * 4096;
#pragma unroll
    for (int a = 0; a < 4; ++a) {
      uint2 o; o.x = pack2(acc[a][0], acc[a][1]); o.y = pack2(acc[a][2], acc[a][3]);
      *(uint2*)(MQK + (4 * ti + a) * 64 + 4 * tj) = o;
    }
    __syncthreads();
  }
  {
    const u16* B = (const u16*)(p.ws + OFF_BPRE);
    const float* cw = p.in[19] + l * 5 * 768;
    u16* DQ = (u16*)(p.ws + OFF_DQKV) + (size_t)item * 3 * 4096;
    float* xs = (float*)(smem + 34304);
#pragma unroll 1
    for (int part = 0; part < 3; ++part) {
      int ch = part * 256 + h * 64 + lane;
      float w0 = cw[ch], w1 = cw[768 + ch], w2 = cw[2 * 768 + ch], w3 = cw[3 * 768 + ch], w4 = cw[4 * 768 + ch];
      __syncthreads();
      for (int e = tid; e < 544; e += 256) {
        int rr = e >> 3, c8 = e & 7;
        int tl = (t0 - stok0) + rr - 2;
        uint4 v = make_uint4(0u, 0u, 0u, 0u);
        if (tl >= 0 && tl < slen) v = *(const uint4*)(B + (size_t)(stok0 + tl) * 768 + part * 256 + h * 64 + c8 * 8);
        float* dst = xs + rr * 64 + c8 * 8;
        dst[0] = bf2f(v.x & 0xffff); dst[1] = bf2f(v.x >> 16); dst[2] = bf2f(v.y & 0xffff); dst[3] = bf2f(v.y >> 16);
        dst[4] = bf2f(v.z & 0xffff); dst[5] = bf2f(v.z >> 16); dst[6] = bf2f(v.w & 0xffff); dst[7] = bf2f(v.w >> 16);
      }
      __syncthreads();
#pragma unroll 4
      for (int i = 0; i < 16; ++i) {
        int t = wave + 4 * i;
        const float* xr = xs + t * 64 + lane;
        float v = siluf(w0 * xr[0] + w1 * xr[64] + w2 * xr[128] + w3 * xr[192] + w4 * xr[256]);
        if (part < 2) {
          float ss = wave_sum(v * v, lane);
          v *= rsqrtf(ss + EPSF);
          if (part == 0) { v *= 0.125f; qs[t * 65 + lane] = v; } else ks[t * 65 + lane] = v;
        }
        DQ[part * 4096 + t * 64 + lane] = f2bf(v);
      }
    }
    __syncthreads();
  }
  float gk[4][4], qk[4][4];
#pragma unroll
  for (int a = 0; a < 4; ++a)
#pragma unroll
    for (int b = 0; b < 4; ++b) { gk[a][b] = 0.f; qk[a][b] = 0.f; }
  for (int d = 0; d < 64; ++d) {
    float x[4], y[4], z[4];
#pragma unroll
    for (int a = 0; a < 4; ++a) { x[a] = qs[(4 * ti + a) * 65 + d]; z[a] = ks[(4 * ti + a) * 65 + d]; y[a] = ks[(4 * tj + a) * 65 + d]; }
#pragma unroll
    for (int a = 0; a < 4; ++a)
#pragma unroll
      for (int b = 0; b < 4; ++b) { qk[a][b] += x[a] * y[b]; gk[a][b] += z[a] * y[b]; }
  }
  __syncthreads();
  u16* PR1 = (u16*)(p.ws + OFF_U);
#pragma unroll
  for (int dir = 0; dir < 2; ++dir) {
    u16* AQ = PR1 + ((size_t)(item * 2 + dir) * 2 + 1) * 4096;
#pragma unroll
    for (int a = 0; a < 4; ++a) {
      int ir = 4 * ti + a;
      int ip = dir ? 63 - ir : ir;
      float gi = gcs[dir * 64 + ip], bi = bes[dir * 64 + ip];
#pragma unroll
      for (int b = 0; b < 4; ++b) {
        int jr = 4 * tj + b;
        int jp = dir ? 63 - jr : jr;
        float e = __expf(gi - gcs[dir * 64 + jp]);
        float akk = (jp < ip) ? bi * gk[a][b] * e : 0.f;
        float aqk = (jp <= ip) ? qk[a][b] * e : 0.f;
        As[(dir * 64 + ip) * 64 + jp] = akk;
        AQ[ip * 64 + jp] = f2bf(aqk);
      }
    }
  }
  __syncthreads();
  if (wave < 2) {
    const float* A = As + wave * 4096;
    u16* T = PR1 + ((size_t)(item * 2 + wave) * 2 + 0) * 4096;
    float tc[64];
#pragma unroll
    for (int i = 0; i < 64; ++i) {
      float acc = (i == lane) ? 1.f : 0.f;
#pragma unroll
      for (int j4 = 0; j4 < (i + 3) / 4; ++j4) {
        float4 a = *(const float4*)(A + i * 64 + j4 * 4);
        if (j4 * 4 + 0 < i) acc -= a.x * tc[j4 * 4 + 0];
        if (j4 * 4 + 1 < i) acc -= a.y * tc[j4 * 4 + 1];
        if (j4 * 4 + 2 < i) acc -= a.z * tc[j4 * 4 + 2];
        if (j4 * 4 + 3 < i) acc -= a.w * tc[j4 * 4 + 3];
      }
      tc[i] = acc;
      T[i * 64 + lane] = f2bf(acc);
    }
  }
}

constexpr int SROW = 136;
constexpr int SIMG = 64 * SROW;

__device__ __forceinline__ bf16x8 frag_perm(const char* img, int row, int s, int q) {
  const char* b = img + row * SROW + s * 64 + q * 8;
  s16x4 lo = *(const s16x4*)(b), hi = *(const s16x4*)(b + 32);
  return (bf16x8){lo[0], lo[1], lo[2], lo[3], hi[0], hi[1], hi[2], hi[3]};
}
__device__ __forceinline__ bf16x8 frag_nat(const char* img, int row, int s, int q) {
  const char* b = img + row * SROW + s * 64 + q * 16;
  s16x4 lo = *(const s16x4*)(b), hi = *(const s16x4*)(b + 8);
  return (bf16x8){lo[0], lo[1], lo[2], lo[3], hi[0], hi[1], hi[2], hi[3]};
}
typedef __attribute__((ext_vector_type(4))) unsigned u32x4_t;
__device__ __forceinline__ bf16x8 acc_frag(const f32x4& x0, const f32x4& x1) {
  u32x4_t w = {pack2(x0[0], x0[1]), pack2(x0[2], x0[3]), pack2(x1[0], x1[1]), pack2(x1[2], x1[3])};
  return __builtin_bit_cast(bf16x8, w);
}
__device__ __forceinline__ uint4 img_ld(const u16* g, int gstride, int tid, int i) {
  int e = tid + 256 * i;
  return *(const uint4*)(g + (size_t)(e >> 3) * gstride + (e & 7) * 8);
}
__device__ __forceinline__ void img_st(char* img, uint4 v, int tid, int i, bool rev_rows, bool rev_cols) {
  int e = tid + 256 * i;
  int row = e >> 3, ch = e & 7;
  int drow = rev_rows ? 63 - row : row;
  if (rev_cols) {
    uint4 w;
    w.x = (v.w >> 16) | (v.w << 16); w.y = (v.z >> 16) | (v.z << 16);
    w.z = (v.y >> 16) | (v.y << 16); w.w = (v.x >> 16) | (v.x << 16);
    v = w; ch = 7 - ch;
  }
  char* d = img + drow * SROW + ch * 16;
  *(uint2*)d = make_uint2(v.x, v.y);
  *(uint2*)(d + 8) = make_uint2(v.z, v.w);
}
__device__ __forceinline__ uint4 imgt_ld(const u16* g, int gstride, int tid, int i) {
  int e = tid + 256 * i;
  return *(const uint4*)(g + (size_t)(e & 63) * gstride + (e >> 6) * 8);
}
__device__ __forceinline__ void imgt_st(char* img, uint4 v, int tid, int i, bool rev_rows) {
  int e = tid + 256 * i;
  int row = e & 63, ch = e >> 6;
  int ip = rev_rows ? 63 - row : row;
  unsigned w[4] = {v.x, v.y, v.z, v.w};
#pragma unroll
  for (int j = 0; j < 4; ++j) {
    *(u16*)(img + (ch * 8 + 2 * j) * SROW + ip * 2) = (u16)(w[j] & 0xffffu);
    *(u16*)(img + (ch * 8 + 2 * j + 1) * SROW + ip * 2) = (u16)(w[j] >> 16);
  }
}

__device__ void delta_scan(const Params& p, int l, int seq, int h, int dir, char* smem) {
  const int tid = otid(), lane = tid & 63, wave = tid >> 6;
  const int r = lane & 15, q = lane >> 4;
  char* iK = smem;
  char* iKT = smem + SIMG;
  char* iQ = smem + 2 * SIMG;
  char* iT = smem + 3 * SIMG;
  char* iA = smem + 4 * SIMG;
  char* iV = smem + 5 * SIMG;
  float* sgc = (float*)(smem + 6 * SIMG);
  float* sbe = sgc + 64;
  float* seg = sgc + 128;
  float* skd = sgc + 192;
  const int nch = seq_len(seq) / 64;
  const int ci0 = seq_tok0(seq) / 64;
  const int dvc = wave * 16 + r;
  f32x4 S[4];
  if (seq >= 16) {
    const float* s0 = p.in[4] + ((size_t)(((seq - 16) * 2 + l) * 2 + dir) * 4 + h) * 4096;
#pragma unroll
    for (int t = 0; t < 4; ++t)
#pragma unroll
      for (int i = 0; i < 4; ++i) S[t][i] = s0[(16 * t + 4 * q + i) * 64 + dvc];
  } else {
#pragma unroll
    for (int t = 0; t < 4; ++t) S[t] = (f32x4){0.f, 0.f, 0.f, 0.f};
  }
  u16* O = (u16*)(p.ws + OFF_BPRE) + (size_t)dir * NT * 256;
  uint4 pre[12];
  float preaux = 0.f;
  auto load_chunk = [&](int n) {
    const int cix = ci0 + (dir ? nch - 1 - n : n);
    const int itm = cix * 4 + h;
    const u16* DQ = (const u16*)(p.ws + OFF_DQKV) + (size_t)itm * 3 * 4096;
    const u16* PR = (const u16*)(p.ws + OFF_U) + (size_t)(itm * 2 + dir) * 2 * 4096;
    const float* aux = (const float*)(p.ws + OFF_DAUX) + (size_t)(itm * 2 + dir) * 128;
#pragma unroll
    for (int i = 0; i < 2; ++i) {
      pre[i] = img_ld(DQ, 64, tid, i);
      pre[2 + i] = img_ld(DQ + 4096, 64, tid, i);
      pre[4 + i] = imgt_ld(DQ + 4096, 64, tid, i);
      pre[6 + i] = imgt_ld(DQ + 8192, 64, tid, i);
      pre[8 + i] = img_ld(PR, 64, tid, i);
      pre[10 + i] = img_ld(PR + 4096, 64, tid, i);
    }
    if (tid < 128) preaux = aux[tid];
  };
  load_chunk(0);
  for (int n = 0; n < nch; ++n) {
    const int ci = ci0 + (dir ? nch - 1 - n : n);
    __syncthreads();
#pragma unroll
    for (int i = 0; i < 2; ++i) {
      img_st(iQ, pre[i], tid, i, dir, false);
      img_st(iK, pre[2 + i], tid, i, dir, false);
      imgt_st(iKT, pre[4 + i], tid, i, dir);
      imgt_st(iV, pre[6 + i], tid, i, dir);
      img_st(iT, pre[8 + i], tid, i, false, false);
      img_st(iA, pre[10 + i], tid, i, false, false);
    }
    if (tid < 128) sgc[tid] = preaux;
    if (tid < 64) {
      float glast = __int_as_float(__builtin_amdgcn_readlane(__float_as_int(preaux), 63));
      seg[tid] = __expf(preaux);
      skd[tid] = __expf(glast - preaux);
    }
    __syncthreads();
    if (n + 1 < nch) load_chunk(n + 1);
    const float gl = sgc[63];
    bf16x8 fK[4][2], fQ[4][2], fT[4][2];
    float4 eg4[4], be4[4], kd4[4];
    float vv[4][4];
#pragma unroll
    for (int m = 0; m < 4; ++m) {
      const int row = 16 * m + r;
      fK[m][0] = frag_perm(iK, row, 0, q); fK[m][1] = frag_perm(iK, row, 1, q);
      fQ[m][0] = frag_perm(iQ, row, 0, q); fQ[m][1] = frag_perm(iQ, row, 1, q);
      fT[m][0] = frag_perm(iT, row, 0, q); fT[m][1] = frag_perm(iT, row, 1, q);
      eg4[m] = *(const float4*)(seg + 16 * m + 4 * q);
      be4[m] = *(const float4*)(sbe + 16 * m + 4 * q);
      kd4[m] = *(const float4*)(skd + 16 * m + 4 * q);
      const s16x4 v4 = *(const s16x4*)(iV + dvc * SROW + (16 * m + 4 * q) * 2);
#pragma unroll
      for (int i = 0; i < 4; ++i) vv[m][i] = bf2f((u16)v4[i]);
    }
    bf16x8 sb0 = acc_frag(S[0], S[1]), sb1 = acc_frag(S[2], S[3]);
    f32x4 rr[4], qs_[4];
#pragma unroll
    for (int m = 0; m < 4; ++m) {
      f32x4 m1 = (f32x4){0.f, 0.f, 0.f, 0.f}, qq = m1;
      m1 = MFMA16(fK[m][0], sb0, m1); m1 = MFMA16(fK[m][1], sb1, m1);
      qq = MFMA16(fQ[m][0], sb0, qq); qq = MFMA16(fQ[m][1], sb1, qq);
      const float eg[4] = {eg4[m].x, eg4[m].y, eg4[m].z, eg4[m].w}, be[4] = {be4[m].x, be4[m].y, be4[m].z, be4[m].w};
#pragma unroll
      for (int i = 0; i < 4; ++i) {
        rr[m][i] = be[i] * (vv[m][i] - eg[i] * m1[i]);
        qs_[m][i] = eg[i] * qq[i];
      }
    }
    bf16x8 fA[4][2], fKT[4][2];
#pragma unroll
    for (int m = 0; m < 4; ++m) {
      const int row = 16 * m + r;
      fA[m][0] = frag_perm(iA, row, 0, q); fA[m][1] = frag_perm(iA, row, 1, q);
      fKT[m][0] = frag_perm(iKT, row, 0, q); fKT[m][1] = frag_perm(iKT, row, 1, q);
    }
    bf16x8 rb0 = acc_frag(rr[0], rr[1]), rb1 = acc_frag(rr[2], rr[3]);
    f32x4 vn[4];
#pragma unroll
    for (int m = 0; m < 4; ++m) {
      f32x4 a = (f32x4){0.f, 0.f, 0.f, 0.f};
      a = MFMA16(fT[m][0], rb0, a); a = MFMA16(fT[m][1], rb1, a);
      vn[m] = a;
    }
    bf16x8 vb0 = acc_frag(vn[0], vn[1]), vb1 = acc_frag(vn[2], vn[3]);
#pragma unroll
    for (int m = 0; m < 4; ++m) {
      f32x4 o = qs_[m];
      o = MFMA16(fA[m][0], vb0, o); o = MFMA16(fA[m][1], vb1, o);
      const float kd[4] = {kd4[m].x, kd4[m].y, kd4[m].z, kd4[m].w};
#pragma unroll
      for (int i = 0; i < 4; ++i) {
        int tr = 16 * m + 4 * q + i;
        int tg = ci * 64 + (dir ? 63 - tr : tr);
        O[(size_t)tg * 256 + h * 64 + dvc] = f2bf(o[i]);
        vn[m][i] *= kd[i];
      }
    }
    bf16x8 vd0 = acc_frag(vn[0], vn[1]), vd1 = acc_frag(vn[2], vn[3]);
    const float egl = __expf(gl);
#pragma unroll
    for (int t = 0; t < 4; ++t) {
      f32x4 a = S[t] * egl;
      a = MFMA16(fKT[t][0], vd0, a); a = MFMA16(fKT[t][1], vd1, a);
      S[t] = a;
    }
  }
  if (seq < 16) {
    float* o = p.out + OUT_DS + ((size_t)((seq * 2 + l) * 2 + dir) * 4 + h) * 4096;
#pragma unroll
    for (int t = 0; t < 4; ++t)
#pragma unroll
      for (int i = 0; i < 4; ++i) o[(16 * t + 4 * q + i) * 64 + dvc] = S[t][i];
  }
}

__device__ void mlstm_scan(const Params& p, int l, int seq, int h, int dir, char* smem) {
  const int tid = otid(), lane = tid & 63, wave = tid >> 6;
  const int r = lane & 15, q = lane >> 4;
  char* iQ = smem;
  char* iQK = smem + SIMG;
  char* iKT = smem + 2 * SIMG;
  char* iVT = smem + 3 * SIMG;
  float* sb = (float*)(smem + 4 * SIMG);
  float* sa = sb + 64;
  float* spm = sb + 128;
  float* sea = sb + 192;
  float* rw = sb + 256 + (otid() >> 6) * 256;
  const int nch = seq_len(seq) / 64;
  const int ci0 = seq_tok0(seq) / 64;
  const int dvc = wave * 16 + r;
  f32x4 C[4], N[4];
  float ms;
  if (seq >= 16) {
    size_t sidx = (size_t)(((seq - 16) * 2 + l) * 2 + dir) * 4 + h;
    const float* c0 = p.in[5] + sidx * 4096;
    const float* n0 = p.in[6] + sidx * 64;
    ms = p.in[7][sidx];
#pragma unroll
    for (int t = 0; t < 4; ++t)
#pragma unroll
      for (int i = 0; i < 4; ++i) {
        C[t][i] = c0[(16 * t + 4 * q + i) * 64 + dvc];
        N[t][i] = (r == 0) ? n0[16 * t + 4 * q + i] : 0.f;
      }
  } else {
    ms = 0.f;
#pragma unroll
    for (int t = 0; t < 4; ++t) { C[t] = (f32x4){0.f, 0.f, 0.f, 0.f}; N[t] = C[t]; }
  }
  const short one_bf = (r == 0) ? (short)0x3f80 : (short)0;
  const bf16x8 ones = (bf16x8){one_bf, one_bf, one_bf, one_bf, one_bf, one_bf, one_bf, one_bf};
  u16* O = (u16*)(p.ws + OFF_MOM) + (size_t)dir * NT * 256;
  const u16* CQ = (const u16*)(p.ws + OFF_CQKV);
  uint4 pre[8];
  float preaux = 0.f;
  auto load_chunk = [&](int n) {
    const int cix = ci0 + (dir ? nch - 1 - n : n);
    const int itm = cix * 4 + h;
    const float* aux = (const float*)(p.ws + OFF_MAUX) + (size_t)(itm * 2 + dir) * 192;
    const u16* cq = CQ + (size_t)cix * 64 * 768 + h * 64;
#pragma unroll
    for (int i = 0; i < 2; ++i) {
      pre[i] = img_ld(cq, 768, tid, i);
      pre[2 + i] = img_ld((const u16*)(p.ws + OFF_MQK) + (size_t)itm * 4096, 64, tid, i);
      pre[4 + i] = imgt_ld(cq + 256, 768, tid, i);
      pre[6 + i] = imgt_ld(cq + 512, 768, tid, i);
    }
    if (tid < 192) preaux = aux[tid];
  };
  load_chunk(0);
  for (int n = 0; n < nch; ++n) {
    const int ci = ci0 + (dir ? nch - 1 - n : n);
    __syncthreads();
#pragma unroll
    for (int i = 0; i < 2; ++i) {
      img_st(iQ, pre[i], tid, i, dir, false);
      img_st(iQK, pre[2 + i], tid, i, dir, dir);
      imgt_st(iKT, pre[4 + i], tid, i, dir);
      imgt_st(iVT, pre[6 + i], tid, i, dir);
    }
    if (tid < 192) sb[tid] = preaux;
    if (tid >= 64 && tid < 128) sea[tid - 64] = __expf(preaux);
    __syncthreads();
    if (n + 1 < nch) load_chunk(n + 1);
    const float blast = sb[63], pmlast = spm[63];
    {
      float brow = sb[lane];
      float mtl = fmaxf(brow + ms, brow + spm[lane]);
      rw[lane] = __expf(brow + ms - mtl);
      rw[64 + lane] = __expf(-mtl);
      rw[128 + lane] = __expf(brow - mtl);
    }
    __builtin_amdgcn_wave_barrier();
    float cf[2][8];
#pragma unroll
    for (int s2 = 0; s2 < 2; ++s2) {
      float4 c0 = *(const float4*)(sea + 32 * s2 + 8 * q), c1 = *(const float4*)(sea + 32 * s2 + 8 * q + 4);
      cf[s2][0] = c0.x; cf[s2][1] = c0.y; cf[s2][2] = c0.z; cf[s2][3] = c0.w;
      cf[s2][4] = c1.x; cf[s2][5] = c1.y; cf[s2][6] = c1.z; cf[s2][7] = c1.w;
    }
    bf16x8 cb0 = acc_frag(C[0], C[1]), cb1 = acc_frag(C[2], C[3]);
    bf16x8 nb0 = acc_frag(N[0], N[1]), nb1 = acc_frag(N[2], N[3]);
    bf16x8 vf0 = frag_nat(iVT, dvc, 0, q), vf1 = frag_nat(iVT, dvc, 1, q);
#pragma unroll
    for (int m = 0; m < 4; ++m) {
      int row = 16 * m + r;
      f32x4 qc = (f32x4){0.f, 0.f, 0.f, 0.f}, qn = qc;
      bf16x8 a0 = frag_perm(iQ, row, 0, q), a1 = frag_perm(iQ, row, 1, q);
      qc = MFMA16(a0, cb0, qc); qc = MFMA16(a1, cb1, qc);
      qn = MFMA16(a0, nb0, qn); qn = MFMA16(a1, nb1, qn);
      const float rfA = rw[128 + row];
      bf16x8 sf[2];
#pragma unroll
      for (int s2 = 0; s2 < 2; ++s2) {
        bf16x8 qkf = frag_nat(iQK, row, s2, q);
        float e[8];
#pragma unroll
        for (int j = 0; j < 8; ++j) {
          int jp = 32 * s2 + 8 * q + j;
          e[j] = (jp <= row) ? bf2f((u16)qkf[j]) * rfA * cf[s2][j] : 0.f;
        }
        u32x4_t w = {pack2(e[0], e[1]), pack2(e[2], e[3]), pack2(e[4], e[5]), pack2(e[6], e[7])};
        sf[s2] = __builtin_bit_cast(bf16x8, w);
      }
      const float4 wi4 = *(const float4*)(rw + 16 * m + 4 * q);
      const float4 em4 = *(const float4*)(rw + 64 + 16 * m + 4 * q);
      const float wi[4] = {wi4.x, wi4.y, wi4.z, wi4.w}, em[4] = {em4.x, em4.y, em4.z, em4.w};
      f32x4 num, den;
#pragma unroll
      for (int i = 0; i < 4; ++i) { num[i] = wi[i] * qc[i]; den[i] = wi[i] * qn[i]; }
      num = MFMA16(sf[0], vf0, num); num = MFMA16(sf[1], vf1, num);
      den = MFMA16(sf[0], ones, den); den = MFMA16(sf[1], ones, den);
#pragma unroll
      for (int i = 0; i < 4; ++i) {
        int tr = 16 * m + 4 * q + i;
        float dr = shl_(den[i], q * 16);
        float hv = num[i] * __builtin_amdgcn_rcpf(fmaxf(fabsf(dr), em[i]));
        int tg = ci * 64 + (dir ? 63 - tr : tr);
        O[(size_t)tg * 256 + h * 64 + dvc] = f2bf(hv);
      }
    }
    float mnew = fmaxf(blast + ms, blast + pmlast);
    float dec = __expf(blast + ms - mnew);
    const float ebl = __expf(blast - mnew);
    bf16x8 wv[2], wo[2];
#pragma unroll
    for (int s2 = 0; s2 < 2; ++s2) {
      bf16x8 vf = s2 ? vf1 : vf0;
      float wk[8], wvv[8];
#pragma unroll
      for (int j = 0; j < 8; ++j) { wk[j] = ebl * cf[s2][j]; wvv[j] = wk[j] * bf2f((u16)vf[j]); }
      u32x4_t w1 = {pack2(wvv[0], wvv[1]), pack2(wvv[2], wvv[3]), pack2(wvv[4], wvv[5]), pack2(wvv[6], wvv[7])};
      u32x4_t w2 = {pack2(wk[0], wk[1]), pack2(wk[2], wk[3]), pack2(wk[4], wk[5]), pack2(wk[6], wk[7])};
      if (r != 0) w2 = (u32x4_t){0u, 0u, 0u, 0u};
      wv[s2] = __builtin_bit_cast(bf16x8, w1);
      wo[s2] = __builtin_bit_cast(bf16x8, w2);
    }
#pragma unroll
    for (int t = 0; t < 4; ++t) {
      int row = 16 * t + r;
      bf16x8 k0 = frag_nat(iKT, row, 0, q), k1 = frag_nat(iKT, row, 1, q);
      f32x4 c = C[t] * dec, nn = N[t] * dec;
      c = MFMA16(k0, wv[0], c); c = MFMA16(k1, wv[1], c);
      nn = MFMA16(k0, wo[0], nn); nn = MFMA16(k1, wo[1], nn);
      C[t] = c; N[t] = nn;
    }
    __builtin_amdgcn_wave_barrier();
    ms = mnew;
  }
  if (seq < 16) {
    size_t sidx = (size_t)((seq * 2 + l) * 2 + dir) * 4 + h;
    float* oc = p.out + OUT_MC + sidx * 4096;
#pragma unroll
    for (int t = 0; t < 4; ++t)
#pragma unroll
      for (int i = 0; i < 4; ++i) oc[(16 * t + 4 * q + i) * 64 + dvc] = C[t][i];
    if (wave == 0 && r == 0) {
#pragma unroll
      for (int t = 0; t < 4; ++t)
#pragma unroll
        for (int i = 0; i < 4; ++i) p.out[OUT_MN + sidx * 64 + 16 * t + 4 * q + i] = N[t][i];
    }
    if (tid == 0) p.out[OUT_MM + sidx] = ms;
  }
}

__device__ void attn_item(const Params& p, int l, int seq, int head, int qb, char* smem) {
  const int tid = otid(), lane = tid & 63, wave = tid >> 6;
  const int r32 = lane & 31, hh = lane >> 5;
  const int qg = wave >> 1, c = wave & 1;
  const int Lk = seq_lk(seq);
  const int ntile = Lk / 64;
  const size_t kr0 = krow0(seq, head);
  const u16* Kb = (const u16*)(p.ws + OFF_K) + kr0 * 128;
  const u16* Vb = (const u16*)(p.ws + OFF_VT) + kr0 * 128;
  u16* Q = (u16*)(p.ws + OFF_Q);
  const int tq = seq_tok0(seq) + qb * 64 + qg * 32 + r32;
  bf16x8 qf[4];
#pragma unroll
  for (int ks = 0; ks < 4; ++ks) qf[ks] = *(const bf16x8*)(Q + (size_t)tq * 512 + head * 128 + c * 64 + ks * 16 + hh * 8);
  f32x16 O[4];
#pragma unroll
  for (int d = 0; d < 4; ++d)
#pragma unroll
    for (int i = 0; i < 16; ++i) O[d][i] = 0.f;
  float mrun = -1.0e30f, lrun = 0.f;

  const unsigned koff0 = (unsigned)((wave * 4 + (lane >> 4)) * 256 + (((lane & 15) ^ ((wave * 4 + (lane >> 4)) & 15)) * 16));
  const unsigned voff0 = (unsigned)((wave * 8 + (lane >> 3)) * Lk * 2 + (((lane & 7) ^ ((wave * 4 + (lane >> 4)) & 7)) * 16));
  const unsigned ldst0 = (unsigned)(wave * 1024 + lane * 16);
  uint4 sg0, sg1, sg2, sg3;
  auto issue = [&](int kt, int buf) {
    char* sK = smem + buf * 32768 + ldst0;
    const unsigned ko = koff0 + (unsigned)kt * 16384u;
#pragma unroll
    for (int i = 0; i < 4; ++i) glds16((const char*)Kb + (ko + (unsigned)(i * 4096)), sK + i * 4096);
  };
#define VLOAD(kt_) do { const unsigned vo_ = voff0 + (unsigned)(kt_) * 128u; const char* vb_ = (const char*)Vb; \
    sg0 = *(const uint4*)(vb_ + vo_); sg1 = *(const uint4*)(vb_ + (vo_ + (unsigned)(64 * Lk))); \
    sg2 = *(const uint4*)(vb_ + (vo_ + (unsigned)(128 * Lk))); sg3 = *(const uint4*)(vb_ + (vo_ + (unsigned)(192 * Lk))); } while (0)
#define VSTORE(buf_) do { char* sV_ = smem + (buf_) * 32768 + 16384 + ldst0; \
    *(uint4*)(sV_) = sg0; *(uint4*)(sV_ + 4096) = sg1; *(uint4*)(sV_ + 8192) = sg2; *(uint4*)(sV_ + 12288) = sg3; } while (0)
  __syncthreads();
  issue(0, 0);
  VLOAD(0);
  VSTORE(0);
  for (int kt = 0; kt < ntile; ++kt) {
    wait_vm0();
    __syncthreads();
    if (kt + 1 < ntile) { issue(kt + 1, (kt + 1) & 1); VLOAD(kt + 1); }
    const unsigned bufo = (unsigned)(kt & 1) * 32768u;
    f32x16 Sx[2];
#pragma unroll
    for (int half = 0; half < 2; ++half) {
      const unsigned kx = bufo + (unsigned)(32 * half + r32) * 256u + (unsigned)c * 128u, kswz = (unsigned)(r32 & 15) << 4;
      bf16x8 ka[4];
#pragma unroll
      for (int ks = 0; ks < 4; ++ks) ka[ks] = *(const bf16x8*)(smem + ((kx + (unsigned)((2 * ks + hh) * 16)) ^ kswz));
#pragma unroll
      for (int i = 0; i < 16; ++i) Sx[half][i] = 0.f;
#pragma unroll
      for (int ks = 0; ks < 4; ++ks) Sx[half] = MFMA32(ka[ks], qf[ks], Sx[half]);
    }
#pragma unroll
    for (int half = 0; half < 2; ++half) {
      bf16x8 pf[2];
      bf16x8 vfr[4][2];
#pragma unroll
      for (int d = 0; d < 4; ++d) {
        const int row = 32 * d + r32;
        const unsigned vswz = (unsigned)((row >> 1) & 7) << 4;
        const unsigned vx = bufo + 16384u + (unsigned)row * 128u + 16u * (unsigned)hh + (unsigned)half * 64u;
#pragma unroll
        for (int s2 = 0; s2 < 2; ++s2) vfr[d][s2] = *(const bf16x8*)(smem + ((vx + (unsigned)(s2 * 32)) ^ vswz));
      }
      __builtin_amdgcn_sched_barrier(0);
      float mx = Sx[half][0];
#pragma unroll
      for (int i = 1; i < 16; ++i) mx = fmaxf(mx, Sx[half][i]);
      mx = fmaxf(mx, shx(mx, 32, lane));
      float mnew = fmaxf(mrun, mx);
      const bool grow = __builtin_amdgcn_ballot_w64(mnew > mrun) != 0ull;
      float ps = 0.f;
#pragma unroll
      for (int i = 0; i < 16; ++i) { float e = __builtin_amdgcn_exp2f(Sx[half][i] - mnew); Sx[half][i] = e; ps += e; }
      if (grow) {
        float alpha = __builtin_amdgcn_exp2f(mrun - mnew);
        mrun = mnew;
        lrun *= alpha;
#pragma unroll
        for (int d = 0; d < 4; ++d)
#pragma unroll
          for (int i = 0; i < 16; ++i) O[d][i] *= alpha;
      }
      lrun += ps;
#pragma unroll
      for (int s2 = 0; s2 < 2; ++s2) {
        u32x4_t w = {pack2(Sx[half][8 * s2], Sx[half][8 * s2 + 1]), pack2(Sx[half][8 * s2 + 2], Sx[half][8 * s2 + 3]),
                     pack2(Sx[half][8 * s2 + 4], Sx[half][8 * s2 + 5]), pack2(Sx[half][8 * s2 + 6], Sx[half][8 * s2 + 7])};
        pf[s2] = __builtin_bit_cast(bf16x8, w);
      }
      __builtin_amdgcn_sched_barrier(0);
#pragma unroll
      for (int d = 0; d < 4; ++d)
#pragma unroll
        for (int s2 = 0; s2 < 2; ++s2) O[d] = MFMA32(vfr[d][s2], pf[s2], O[d]);
    }
    if (kt + 1 < ntile) VSTORE((kt + 1) & 1);
  }
  const int tid2 = otid();
  const int lane2 = tid2 & 63, r32b = lane2 & 31, hhb = lane2 >> 5, qgb = tid2 >> 7, cb = (tid2 >> 6) & 1;
  const int tqb = seq_tok0(seq) + qb * 64 + qgb * 32 + r32b;
  float lsum = lrun + shx(lrun, 32, lane2);
  const int l2 = *(volatile LAS int*)(LAS int*)(smem + LDS_CTL + 4);
  const float lam = ((const float*)(p.ws + OFF_LAM))[l2];
  const float lam_init = l2 == 0 ? 0.2f : 0.35550907f;
  float inv = (cb == 0 ? 1.f : lam) / lsum;
  float* xch = (float*)smem + qgb * (32 * 132) + r32b * 132;
  __syncthreads();
  if (cb == 1) {
#pragma unroll
    for (int d = 0; d < 4; ++d)
#pragma unroll
      for (int g = 0; g < 4; ++g) {
        int dv = 32 * d + 8 * g + 4 * hhb;
        *(float4*)(xch + dv) = make_float4(O[d][4 * g] * inv, O[d][4 * g + 1] * inv, O[d][4 * g + 2] * inv, O[d][4 * g + 3] * inv);
      }
  }
  __syncthreads();
  if (cb == 0) {
    float ss = 0.f;
#pragma unroll
    for (int d = 0; d < 4; ++d)
#pragma unroll
      for (int g = 0; g < 4; ++g) {
        int dv = 32 * d + 8 * g + 4 * hhb;
        float4 o1 = *(const float4*)(xch + dv);
        float v0 = O[d][4 * g] * inv - o1.x, v1 = O[d][4 * g + 1] * inv - o1.y;
        float v2 = O[d][4 * g + 2] * inv - o1.z, v3 = O[d][4 * g + 3] * inv - o1.w;
        O[d][4 * g] = v0; O[d][4 * g + 1] = v1; O[d][4 * g + 2] = v2; O[d][4 * g + 3] = v3;
        ss += v0 * v0 + v1 * v1 + v2 * v2 + v3 * v3;
      }
    ss += shx(ss, 32, lane2);
    float rs = rsqrtf(ss * (1.f / 128.f) + EPSF) * (1.f - lam_init);
    const float* ag = p.in[18] + l2 * 128;
#pragma unroll
    for (int d = 0; d < 4; ++d)
#pragma unroll
      for (int g = 0; g < 4; ++g) {
        int dv = 32 * d + 8 * g + 4 * hhb;
        float4 gg = *(const float4*)(ag + dv);
        uint2 o;
        o.x = pack2(O[d][4 * g + 0] * rs * gg.x, O[d][4 * g + 1] * rs * gg.y);
        o.y = pack2(O[d][4 * g + 2] * rs * gg.z, O[d][4 * g + 3] * rs * gg.w);
        *(uint2*)(Q + (size_t)tqb * 512 + head * 128 + dv) = o;
      }
  }
}

__device__ void merge_phase(const Params& p, int l, int bid, int nb) {
  const int tid_ = otid();
  const int wave = tid_ >> 6, lane = tid_ & 63;
  const u16* Od = (const u16*)(p.ws + OFF_BPRE);
  const u16* Om = (const u16*)(p.ws + OFF_MOM);
  const u16* BG = (const u16*)(p.ws + OFF_BG);
  const u16* CO = (const u16*)(p.ws + OFF_CO);
  u16* cat2 = (u16*)(p.ws + OFF_U);
  const float* dg = p.in[22] + l * 64;
  const float* mg = p.in[24] + l * 64;
  for (int t = bid * 4 + wave; t < NT; t += nb * 4) {
    int c = lane * 4;
    uint2 a = *(const uint2*)(Od + (size_t)t * 256 + c), b = *(const uint2*)(Od + (size_t)(NT + t) * 256 + c);
    uint2 gt = *(const uint2*)(BG + (size_t)t * 256 + c);
    float v[4] = {bf2f(a.x & 0xffff) + bf2f(b.x & 0xffff), bf2f(a.x >> 16) + bf2f(b.x >> 16),
                  bf2f(a.y & 0xffff) + bf2f(b.y & 0xffff), bf2f(a.y >> 16) + bf2f(b.y >> 16)};
    float g[4] = {bf2f(gt.x & 0xffff), bf2f(gt.x >> 16), bf2f(gt.y & 0xffff), bf2f(gt.y >> 16)};
    float ss = v[0] * v[0] + v[1] * v[1] + v[2] * v[2] + v[3] * v[3];
#pragma unroll
    for (int o = 8; o > 0; o >>= 1) ss += shx(ss, o, lane);
    float rs = rsqrtf(ss * (1.f / 64.f) + EPSF);
    float4 w = *(const float4*)(dg + (c & 63));
    uint2 o;
    o.x = pack2(v[0] * rs * w.x * siluf(g[0]), v[1] * rs * w.y * siluf(g[1]));
    o.y = pack2(v[2] * rs * w.z * siluf(g[2]), v[3] * rs * w.w * siluf(g[3]));
    *(uint2*)(cat2 + (size_t)t * 512 + c) = o;
    a = *(const uint2*)(Om + (size_t)t * 256 + c); b = *(const uint2*)(Om + (size_t)(NT + t) * 256 + c);
    gt = *(const uint2*)(CO + (size_t)t * 256 + c);
    float v2[4] = {bf2f(a.x & 0xffff) + bf2f(b.x & 0xffff), bf2f(a.x >> 16) + bf2f(b.x >> 16),
                   bf2f(a.y & 0xffff) + bf2f(b.y & 0xffff), bf2f(a.y >> 16) + bf2f(b.y >> 16)};
    float g2[4] = {bf2f(gt.x & 0xffff), bf2f(gt.x >> 16), bf2f(gt.y & 0xffff), bf2f(gt.y >> 16)};
    ss = v2[0] * v2[0] + v2[1] * v2[1] + v2[2] * v2[2] + v2[3] * v2[3];
#pragma unroll
    for (int o2 = 8; o2 > 0; o2 >>= 1) ss += shx(ss, o2, lane);
    rs = rsqrtf(ss * (1.f / 64.f) + EPSF);
    w = *(const float4*)(mg + (c & 63));
    o.x = pack2(v2[0] * rs * w.x * sigmf(g2[0]), v2[1] * rs * w.y * sigmf(g2[1]));
    o.y = pack2(v2[2] * rs * w.z * sigmf(g2[2]), v2[3] * rs * w.w * sigmf(g2[3]));
    *(uint2*)(cat2 + (size_t)t * 512 + 256 + c) = o;
  }
}

__device__ void final_norm(const Params& p, int bid, int nb) {
  const int tid_ = otid();
  const int wave = tid_ >> 6, lane = tid_ & 63;
  const float* g = p.in[27];
  for (int t = bid * 4 + wave; t < NT; t += nb * 4) {
    float* x = p.out + (size_t)t * DM;
    float4 v[4];
    float ss = 0.f;
#pragma unroll
    for (int i = 0; i < 4; ++i) {
      v[i] = *(const float4*)(x + i * 256 + lane * 4);
      ss += v[i].x * v[i].x + v[i].y * v[i].y + v[i].z * v[i].z + v[i].w * v[i].w;
    }
    ss = wave_sum(ss, lane);
    float rs = rsqrtf(ss * (1.f / 1024.f) + EPSF);
#pragma unroll
    for (int i = 0; i < 4; ++i) {
      float4 gg = *(const float4*)(g + i * 256 + lane * 4);
      float4 o = make_float4(v[i].x * rs * gg.x, v[i].y * rs * gg.y, v[i].z * rs * gg.z, v[i].w * rs * gg.w);
      *(float4*)(x + i * 256 + lane * 4) = o;
    }
  }
}

__device__ void mixer_queue(const Params& p, int l, char* smem, int xcc) {
  int& s_item = *(int*)(smem + LDS_CTL);
  if (otid() == 0) *(volatile LAS int*)(LAS int*)(smem + LDS_CTL + 4) = l;
#pragma unroll 1
  for (int qi = 0; qi < 8; ++qi) {
    const int qx = (xcc + qi) & 7;
    unsigned* cnt = (unsigned*)(p.ws + OFF_CNT) + __builtin_amdgcn_readfirstlane(l * 8 + qx);
    for (;;) {
      __syncthreads();
      if (otid() == 0) s_item = (int)atomicAdd(cnt, 1u);
      __syncthreads();
      int u = __builtin_amdgcn_readfirstlane(s_item);
      if (u >= 200) break;
      int kind, seq, a1, a2;
      if (u < 8) { int idx = qx * 4 + (u >> 1); kind = u & 1; seq = 16 + (idx >> 3); a1 = (idx >> 1) & 3; a2 = idx & 1; }
      else if (u < 136) { int j = u - 8; int pair = 2 * qx + (j >> 6); kind = 2; seq = 16 + (pair >> 2); a1 = pair & 3; a2 = j & 63; }
      else if (u < 168) { int g = qx * 32 + (u - 136); int idx = g >> 1; kind = g & 1; seq = idx >> 3; a1 = (idx >> 1) & 3; a2 = idx & 1; }
      else { int g = qx * 32 + (u - 168); kind = 2; seq = g >> 4; a1 = (g >> 2) & 3; a2 = g & 3; }
      if (kind == 0) delta_scan(p, l, seq, a1, a2, smem);
      else if (kind == 1) mlstm_scan(p, l, seq, a1, a2, smem);
      else attn_item(p, l, seq, a1, a2, smem);
    }
  }
}

__global__ void __launch_bounds__(256, 2) mega(Params p0) {
  extern __shared__ __attribute__((aligned(16))) char smem[];
  const int bid = blockIdx.x, nb = gridDim.x;
  if (threadIdx.x == 0) { *(volatile LAS unsigned*)(LAS unsigned*)(smem + LDS_CTL + 8) = 0u; *(volatile LAS unsigned*)(LAS unsigned*)(smem + LDS_CTL + 12) = 0u; }
  __syncthreads();
  const XcdBarrier xb = xcd_barrier_post((unsigned*)(p0.ws + OFF_BAR), (volatile LAS unsigned*)(LAS unsigned*)(smem + LDS_CTL + 8));
  if (p0.rep[3] < 0) cg::this_grid().sync();

#pragma unroll 1
  for (int ph = 0; ph < 20; ++ph) {
    const Params& p = p0;
    const int l = ph < 10 ? 0 : 1;
    const int k = ph == 0 ? -1 : (ph == 19 ? 9 : (ph - 1) % 9);
    switch (k) {
      case -1:
        for (int t = bid; t < 192; t += nb) mod_task(p, t, smem);
        if (bid == nb - 1) misc_task(p);
        wconv_job(p.in[14], (u16*)(p.ws + OFF_WIN), 1024, INW, INP, 1, smem, bid, nb);
        break;
      case 0:
        norm_phase(p, l, 0, bid, nb);
        cache_conv(p, l, smem, bid, nb);
        break;
      case 1:
        gemm_phase<EPI_IN>(p, l, (const u16*)(p.ws + OFF_U), 1024, (const u16*)(p.ws + OFF_U), 1024, 1 << 30,
                           (const u16*)(p.ws + OFF_WIN), 1024, INP / 128, smem, bid, nb);
        break;
      case 2:
        for (int it = bid; it < 1280; it += nb) prep_item(p, l, it >> 2, it & 3, smem);
        break;
      case 3:
        mixer_queue(p, l, smem, (int)(xb.x & 7u));
        break;
      case 4:
        merge_phase(p, l, bid, nb);
        wconv_job(p.in[16] + (size_t)l * 1024 * 1024, (u16*)(p.ws + OFF_WOUT), 1024, 1024, 1024, 0, smem, bid, nb);
        wconv_job(p.in[25] + (size_t)l * 1024 * 2 * FF, (u16*)(p.ws + OFF_WGU), 1024, 2 * FF, 2 * FF, 2, smem, bid, nb);
        wconv_job(p.in[26] + (size_t)l * FF * 1024, (u16*)(p.ws + OFF_WDN), FF, 1024, 1024, 0, smem, bid, nb);
        if (l == 0) wconv_job(p.in[14] + (size_t)1024 * INW, (u16*)(p.ws + OFF_WIN), 1024, INW, INP, 1, smem, bid, nb);
        break;
      case 5:
        gemm_phase<EPI_RES1>(p, l, (const u16*)(p.ws + OFF_Q), 512, (const u16*)(p.ws + OFF_U), 512, 512,
                             (const u16*)(p.ws + OFF_WOUT), 1024, 8, smem, bid, nb);
        break;
      case 6:
        norm_phase(p, l, 1, bid, nb);
        break;
      case 7:
        gemm_phase_big<EPI_SWIGLU>(p, l, (const u16*)(p.ws + OFF_U), 1024, (const u16*)(p.ws + OFF_WGU), 1024, 2 * FF / 128, smem, bid, nb);
        break;
      case 8:
        gemm_phase<EPI_RES2>(p, l, (const u16*)(p.ws), FF, (const u16*)(p.ws), FF, 1 << 30,
                             (const u16*)(p.ws + OFF_WDN), FF, 8, smem, bid, nb);
        break;
      default:
        final_norm(p, bid, nb);
        break;
    }
    if (ph < 19) xcd_barrier(xb);
  }
}

extern "C" void kernel_launch(void* const* d_in, const int* in_sizes, int n_in, void* d_out, int out_size,
                              void* d_ws, size_t ws_size, hipStream_t stream) {
  static int grid_blocks = 0;
  if (!grid_blocks) {
    int dev = 0, cus = 0, per_cu = 0;
    (void)hipGetDevice(&dev);
    (void)hipDeviceGetAttribute(&cus, hipDeviceAttributeMultiprocessorCount, dev);
    (void)hipFuncSetAttribute((const void*)mega, hipFuncAttributeMaxDynamicSharedMemorySize, LDS_BYTES);
    (void)hipOccupancyMaxActiveBlocksPerMultiprocessor(&per_cu, mega, 256, LDS_BYTES);
    if (per_cu > 2) per_cu = 2;
    if (per_cu < 1) per_cu = 1;
    grid_blocks = cus * per_cu;
  }
  if (ws_size < WS_NEED) { fprintf(stderr, "workspace too small: %zu < %zu\n", ws_size, (size_t)WS_NEED); return; }
  Params p{};
  for (int i = 0; i < 28; ++i) p.in[i] = (const float*)d_in[i];
  p.out = (float*)d_out;
  p.ws = (char*)d_ws;
  p.rep[0] = REP0; p.rep[1] = REP1; p.rep[2] = REP2; p.rep[3] = REP3;
  (void)hipMemsetAsync((char*)d_ws + OFF_BAR, 0, (size_t)XCD_BAR_WORDS_C * 4, stream);
  void* args[] = {&p};
  hipError_t e = hipLaunchCooperativeKernel((void*)mega, dim3(grid_blocks), dim3(256), args, LDS_BYTES, stream);
  if (e != hipSuccess) fprintf(stderr, "cooperative launch failed: %s (grid %d)\n", hipGetErrorString(e), grid_blocks);
}
```

```cpp
#include <hip/hip_runtime.h>
#include <hip/hip_cooperative_groups.h>
#include <cstdio>
namespace cg = cooperative_groups;

typedef __attribute__((ext_vector_type(8))) short bf16x8;
typedef __attribute__((ext_vector_type(4))) short s16x4;
typedef __attribute__((ext_vector_type(4))) float f32x4;
typedef __attribute__((ext_vector_type(16))) float f32x16;
typedef unsigned short u16;

#define MFMA16(a, b, c) __builtin_amdgcn_mfma_f32_16x16x32_bf16((a), (b), (c), 0, 0, 0)
#define MFMA32(a, b, c) __builtin_amdgcn_mfma_f32_32x32x16_bf16((a), (b), (c), 0, 0, 0)

constexpr int DM = 1024;
constexpr int NT = 20480;
constexpr int NTC = 4096;
constexpr int INW = 3616;
constexpr int INP = 3712;
constexpr int FF = 2816;
constexpr float EPSF = 1e-6f;
constexpr float LOG2E = 1.4426950408889634f;
constexpr int LDS_CTL = 73728;
constexpr int LDS_BYTES = LDS_CTL + 16;
constexpr int XCD_BAR_WORDS_C = 3456;

constexpr size_t OFF_Q = 0;
constexpr size_t OFF_K = OFF_Q + (size_t)NT * 512 * 2;
constexpr size_t OFF_VT = OFF_K + (size_t)90112 * 128 * 2;
constexpr size_t OFF_BPRE = OFF_VT + (size_t)90112 * 128 * 2;
constexpr size_t OFF_BG = OFF_BPRE + (size_t)NT * 768 * 2;
constexpr size_t OFF_CQKV = OFF_BG + (size_t)NT * 256 * 2;
constexpr size_t OFF_CO = OFF_CQKV + (size_t)NT * 768 * 2;
constexpr size_t OFF_GATE = OFF_CO + (size_t)NT * 256 * 2;
constexpr size_t OFF_U = OFF_GATE + (size_t)NT * 32 * 4;
constexpr size_t OFF_P2 = OFF_U + (size_t)NT * 1024 * 2;
constexpr size_t OFF_MOM = OFF_P2 + (size_t)NT * 1024 * 2;
constexpr size_t OFF_SMALL = OFF_MOM + (size_t)NT * 512 * 2;
constexpr size_t OFF_MODV = OFF_SMALL;
constexpr size_t OFF_ROPE = OFF_MODV + 2 * 5 * 6144 * 4;
constexpr size_t OFF_LAM = OFF_ROPE + 1024 * 8;
constexpr size_t OFF_CNT = OFF_LAM + 64;
constexpr size_t OFF_DAUX = OFF_CNT + 64;
constexpr size_t OFF_MAUX = OFF_DAUX + (size_t)2560 * 128 * 4;
constexpr size_t OFF_BAR = OFF_MAUX + (size_t)2560 * 192 * 4;
constexpr size_t WS_NEED = OFF_BAR + (size_t)XCD_BAR_WORDS_C * 4;
constexpr size_t OFF_WIN = OFF_P2;
constexpr size_t OFF_WOUT = OFF_WIN + (size_t)INP * 1024 * 2;
constexpr size_t OFF_WGU = OFF_WOUT + (size_t)1024 * 1024 * 2;
constexpr size_t OFF_WDN = OFF_WGU + (size_t)2 * FF * 1024 * 2;
constexpr size_t OFF_DQKV = OFF_P2;
constexpr size_t OFF_MQK = OFF_P2 + (size_t)1280 * 3 * 4096 * 2;

constexpr size_t OUT_NK = (size_t)NT * 1024;
constexpr size_t OUT_NV = OUT_NK + 4194304;
constexpr size_t OUT_DS = OUT_NV + 4194304;
constexpr size_t OUT_MC = OUT_DS + 1048576;
constexpr size_t OUT_MN = OUT_MC + 1048576;
constexpr size_t OUT_MM = OUT_MN + 16384;

struct Params {
  const float* in[28];
  float* out;
  char* ws;
  int rep[4];
};
constexpr int REP0 = 1, REP1 = 1, REP2 = 1, REP3 = 1;

typedef __attribute__((ext_vector_type(2))) float f32x2_t;
typedef __attribute__((ext_vector_type(2))) __bf16 bf16x2_t;
__device__ __forceinline__ unsigned pack2(float a, float b) {
  f32x2_t v = {a, b};
  bf16x2_t h = __builtin_convertvector(v, bf16x2_t);
  return __builtin_bit_cast(unsigned, h);
}
__device__ __forceinline__ u16 f2bf(float f) { return (u16)(pack2(f, 0.f) & 0xffffu); }
__device__ __forceinline__ float bf2f(u16 h) { return __uint_as_float(((unsigned)h) << 16); }
__device__ __forceinline__ float siluf(float x) { return x * __builtin_amdgcn_rcpf(1.f + __expf(-x)); }
__device__ __forceinline__ float sigmf(float x) { return __builtin_amdgcn_rcpf(1.f + __expf(-x)); }
__device__ __forceinline__ float softplusf(float x) { return fmaxf(x, 0.f) + log1pf(__expf(-fabsf(x))); }
__device__ __forceinline__ float shx(float v, int o, int lane) {
  return __int_as_float(__builtin_amdgcn_ds_bpermute((lane ^ o) << 2, __float_as_int(v)));
}
__device__ __forceinline__ float shl_(float v, int src) {
  return __int_as_float(__builtin_amdgcn_ds_bpermute(src << 2, __float_as_int(v)));
}
__device__ __forceinline__ float wave_sum(float v, int lane) {
#pragma unroll
  for (int o = 32; o > 0; o >>= 1) v += shx(v, o, lane);
  return v;
}
__device__ __forceinline__ void glds16(const void* g, void* l) {
  __builtin_amdgcn_global_load_lds((const unsigned*)g, (__attribute__((address_space(3))) unsigned*)l, 16, 0, 0);
}
__device__ __forceinline__ int otid() { int t = threadIdx.x; asm volatile("" : "+v"(t)); return t; }
#define LAUNDER(q, p) const Params& q = (p);
__device__ __forceinline__ void wait_vm0() { asm volatile("s_waitcnt vmcnt(0)" ::: "memory"); }


#define XB_TMO      128
#define XB_XCNT(j)  (256  + 64 * (j))
#define XB_XSUB(j)  (1280 + 64 * (j))
#define XB_XGEN(j)  (2304 + 64 * (j))
#define XB_TOP      3328
#define XB_TOPGEN   3392
#define XCD_BAR_WORDS 3456
#define XB_SPIN_CAP (1u << 20)
#define LAS __attribute__((address_space(3)))
__device__ __forceinline__ unsigned xb_ld(unsigned* p)              { return __hip_atomic_load(p, __ATOMIC_RELAXED, __HIP_MEMORY_SCOPE_AGENT); }
__device__ __forceinline__ unsigned xb_add(unsigned* p, unsigned v) { return __hip_atomic_fetch_add(p, v, __ATOMIC_RELAXED, __HIP_MEMORY_SCOPE_AGENT); }
__device__ __forceinline__ unsigned xb_xcc_id() { return (unsigned)__builtin_amdgcn_s_getreg((3 << 11) | 20) & 0xFu; }
#define XB_SPIN(cond, bar) do { unsigned _sp = 0; while (cond) { __builtin_amdgcn_s_sleep(1); \
    if ((++_sp & 255u) == 0u) { if (xb_ld(&(bar)[XB_TMO])) break; if (_sp > XB_SPIN_CAP) { atomicAdd(&(bar)[XB_TMO], 1u); break; } } } } while (0)
struct XcdBarrier { unsigned* bar; unsigned x; volatile LAS unsigned* st; };
__device__ __forceinline__ XcdBarrier xcd_barrier_post(unsigned* bar, volatile LAS unsigned* st) {
  XcdBarrier b; b.bar = bar; b.x = xb_xcc_id(); b.st = st;
  if (threadIdx.x == 0) (void)xb_add(&bar[XB_XCNT(b.x)], 1u);
  return b;
}
__device__ __forceinline__ void xcd_barrier_complete(unsigned* bar, unsigned x, unsigned& nloc, unsigned& nx) {
  const unsigned G = gridDim.x * gridDim.y * gridDim.z;
  unsigned sum, cnt, mine, sp = 0u;
  for (;;) {
    sum = 0u; cnt = 0u; mine = 0u;
#pragma unroll
    for (unsigned j = 0; j < 16; ++j) { const unsigned c = xb_ld(&bar[XB_XCNT(j)]); sum += c; cnt += (c > 0u) ? 1u : 0u; mine = (j == x) ? c : mine; }
    if (sum == G) break;
    __builtin_amdgcn_s_sleep(1);
    if ((++sp & 255u) == 0u) { if (xb_ld(&bar[XB_TMO])) break; if (sp > XB_SPIN_CAP) { atomicAdd(&bar[XB_TMO], 1u); break; } }
  }
  nloc = mine > 0u ? mine : 1u; nx = cnt > 0u ? cnt : 1u;
}
__device__ __forceinline__ void xcd_barrier(const XcdBarrier& b) {
  asm volatile("s_waitcnt vmcnt(0)" ::: "memory");
  __syncthreads();
  if (threadIdx.x == 0) {
    unsigned* bar = b.bar;
    __builtin_amdgcn_s_waitcnt(0);
    unsigned nloc = b.st[0], nx = b.st[1];
    if (nloc == 0u) { xcd_barrier_complete(bar, b.x, nloc, nx); b.st[0] = nloc; b.st[1] = nx; }
    const unsigned old = xb_add(&bar[XB_XSUB(b.x)], 1u);
    const unsigned gen = old / nloc;
    if (old + 1u == (gen + 1u) * nloc) {
      __builtin_amdgcn_fence(__ATOMIC_RELEASE, "agent");
      asm volatile("s_waitcnt vmcnt(0)" ::: "memory");
      const unsigned og = xb_add(&bar[XB_TOP], 1u);
      const unsigned tg = og / nx;
      if (og + 1u == (tg + 1u) * nx) xb_add(&bar[XB_TOPGEN], 1u);
      else XB_SPIN(xb_ld(&bar[XB_TOPGEN]) == tg, bar);
      __builtin_amdgcn_fence(__ATOMIC_ACQUIRE, "agent");
      xb_add(&bar[XB_XGEN(b.x)], 1u);
      asm volatile("s_waitcnt vmcnt(0)" ::: "memory");
    } else {
      XB_SPIN(xb_ld(&bar[XB_XGEN(b.x)]) == gen, bar);
      __builtin_amdgcn_fence(__ATOMIC_ACQUIRE, "agent");
      asm volatile("s_waitcnt vmcnt(0)" ::: "memory");
    }
  }
  __syncthreads();
}

__device__ __forceinline__ int tok_seq(int t) { return t < NTC ? (t >> 8) : 16 + ((t - NTC) >> 12); }
__device__ __forceinline__ int seq_tok0(int s) { return s < 16 ? s * 256 : NTC + (s - 16) * 4096; }
__device__ __forceinline__ int seq_len(int s) { return s < 16 ? 256 : 4096; }
__device__ __forceinline__ int seq_lk(int s) { return s < 16 ? 256 : 4608; }
__device__ __forceinline__ int seq_mv(int s) { return s < 16 ? 0 : s - 15; }
__device__ __forceinline__ size_t krow0(int s, int h) {
  return s < 16 ? (size_t)(s * 4 + h) * 256 : (size_t)16384 + (size_t)((s - 16) * 4 + h) * 4608;
}
__device__ __forceinline__ const float* xrow_ptr(const Params& p, int l, int t) {
  if (l == 0) return t < NTC ? p.in[0] + (size_t)t * DM : p.in[1] + (size_t)(t - NTC) * DM;
  return p.out + (size_t)t * DM;
}
__device__ __forceinline__ int in_src_col(int n) {
  if (n < 2560) return n;
  if (n < 3584) return n + 16;
  if (n < 3600) return n - 3584 + 2560;
  if (n < 3616) return n;
  return -1;
}

__device__ void wconv_tile(const float* W, int K, int N, u16* Wt, int mode, int kt, int nt, char* smem) {
  float* tile = (float*)smem;
  const int tid = otid();
  __syncthreads();
  for (int e = tid; e < 1024; e += 256) {
    int kk = e >> 4, nn = (e & 15) * 4;
    int nd = nt * 64 + nn;
    int src;
    if (mode == 0) src = nd;
    else if (mode == 1) src = in_src_col(nd);
    else { int t128 = nd >> 7, w = nd & 127; int pp = w >> 5, half = (w >> 4) & 1, r = w & 15; src = half * FF + t128 * 64 + pp * 16 + r; }
    float4 v = make_float4(0.f, 0.f, 0.f, 0.f);
    if (src >= 0) v = *(const float4*)(W + (size_t)(kt * 64 + kk) * N + src);
    float* d = tile + kk * 65 + nn;
    d[0] = v.x; d[1] = v.y; d[2] = v.z; d[3] = v.w;
  }
  __syncthreads();
  for (int e = tid; e < 2048; e += 256) {
    int nn = e >> 5, k2 = (e & 31) * 2;
    unsigned v = pack2(tile[k2 * 65 + nn], tile[(k2 + 1) * 65 + nn]);
    *(unsigned*)(Wt + (size_t)(nt * 64 + nn) * K + kt * 64 + k2) = v;
  }
}

__device__ void wconv_job(const float* W, u16* Wt, int K, int N, int Np, int mode, char* smem, int bid, int nb) {
  int nkt = K / 64, nnt = Np / 64;
  for (int t = bid; t < nkt * nnt; t += nb) wconv_tile(W, K, N, Wt, mode, t / nnt, t % nnt, smem);
}

__device__ void mod_task(const Params& p, int task, char* smem) {
  float* sc = (float*)smem;
  float* red = sc + 5 * 1024;
  const int tid = otid();
  __syncthreads();
  for (int e = tid; e < 5 * 1024; e += 256) {
    int mv = e >> 10, k = e & 1023;
    float c = mv == 0 ? p.in[9][k] : p.in[8][(mv - 1) * 1024 + k];
    sc[e] = siluf(c);
  }
  __syncthreads();
  int l = task / 96, cg0 = (task % 96) * 64;
  int quad = tid & 15, kg = tid >> 4;
  const float* W = p.in[12] + (size_t)l * 1024 * 6144 + cg0 + quad * 4;
  float acc[5][4];
#pragma unroll
  for (int a = 0; a < 5; ++a)
#pragma unroll
    for (int b = 0; b < 4; ++b) acc[a][b] = 0.f;
  for (int kk = 0; kk < 64; ++kk) {
    int k = kg * 64 + kk;
    float4 w = *(const float4*)(W + (size_t)k * 6144);
#pragma unroll
    for (int a = 0; a < 5; ++a) {
      float s = sc[a * 1024 + k];
      acc[a][0] += s * w.x; acc[a][1] += s * w.y; acc[a][2] += s * w.z; acc[a][3] += s * w.w;
    }
  }
#pragma unroll
  for (int a = 0; a < 5; ++a)
#pragma unroll
    for (int b = 0; b < 4; ++b) red[(kg * 5 + a) * 64 + quad * 4 + b] = acc[a][b];
  __syncthreads();
  float* modv = (float*)(p.ws + OFF_MODV);
  for (int e = tid; e < 320; e += 256) {
    int a = e >> 6, c = e & 63;
    float s = p.in[13][l * 6144 + cg0 + c];
    for (int g = 0; g < 16; ++g) s += red[(g * 5 + a) * 64 + c];
    modv[(size_t)(l * 5 + a) * 6144 + cg0 + c] = s;
  }
}

__device__ void misc_task(const Params& p) {
  const int tid = otid();
  float2* rope = (float2*)(p.ws + OFF_ROPE);
  for (int e = tid; e < 1024; e += 256) {
    int pos = e >> 4, f = e & 15;
    float inv = powf(10000.f, -(float)f / 16.f);
    float ang = (float)pos * inv;
    rope[e] = make_float2(cosf(ang), sinf(ang));
  }
  if (tid < 2) {
    const float* lq = p.in[17] + tid * 256;
    float s1 = 0.f, s2 = 0.f;
    for (int i = 0; i < 64; ++i) { s1 += lq[i] * lq[64 + i]; s2 += lq[128 + i] * lq[192 + i]; }
    float lam_init = 0.8f - 0.6f * expf(-0.3f * (float)tid);
    ((float*)(p.ws + OFF_LAM))[tid] = expf(s1) - expf(s2) + lam_init;
  }
  if (tid < 16) ((unsigned*)(p.ws + OFF_CNT))[tid] = 0u;
}

__device__ void norm_phase(const Params& p, int l, int which, int bid, int nb) {
  const int tid_ = otid();
  const int wave = tid_ >> 6, lane = tid_ & 63;
  const float* g = p.in[which == 0 ? 10 : 11] + l * 1024;
  const float* modv = (const float*)(p.ws + OFF_MODV);
  u16* U = (u16*)(p.ws + OFF_U);
  for (int t = bid * 4 + wave; t < NT; t += nb * 4) {
    const float* x = xrow_ptr(p, which == 0 ? l : 1, t);
    int mv = seq_mv(tok_seq(t));
    const float* sh = modv + (size_t)(l * 5 + mv) * 6144 + (which == 0 ? 0 : 3) * 1024;
    const float* sc = sh + 1024;
    float4 v[4];
    float ss = 0.f;
#pragma unroll
    for (int i = 0; i < 4; ++i) {
      v[i] = *(const float4*)(x + i * 256 + lane * 4);
      ss += v[i].x * v[i].x + v[i].y * v[i].y + v[i].z * v[i].z + v[i].w * v[i].w;
    }
    ss = wave_sum(ss, lane);
    float rs = rsqrtf(ss * (1.f / 1024.f) + EPSF);
#pragma unroll
    for (int i = 0; i < 4; ++i) {
      int c = i * 256 + lane * 4;
      float4 gg = *(const float4*)(g + c), s4 = *(const float4*)(sc + c), h4 = *(const float4*)(sh + c);
      float a0 = v[i].x * rs * gg.x * (1.f + s4.x) + h4.x;
      float a1 = v[i].y * rs * gg.y * (1.f + s4.y) + h4.y;
      float a2 = v[i].z * rs * gg.z * (1.f + s4.z) + h4.z;
      float a3 = v[i].w * rs * gg.w * (1.f + s4.w) + h4.w;
      uint2 o; o.x = pack2(a0, a1); o.y = pack2(a2, a3);
      *(uint2*)(U + (size_t)t * 1024 + c) = o;
    }
  }
}

__device__ void cache_conv(const Params& p, int l, char* smem, int bid, int nb) {
  u16* K = (u16*)(p.ws + OFF_K);
  u16* VT = (u16*)(p.ws + OFF_VT);
  const int tid_ = otid();
  for (int e = bid * 256 + tid_; e < 262144; e += nb * 256) {
    int c4 = (e & 31) * 4, h = (e >> 5) & 3, pt = (e >> 7) & 511, b = e >> 16;
    float4 v = *(const float4*)(p.in[2] + ((size_t)((b * 2 + l) * 512 + pt) * 4 + h) * 128 + c4);
    uint2 o; o.x = pack2(v.x, v.y); o.y = pack2(v.z, v.w);
    *(uint2*)(K + (krow0(16 + b, h) + 4096 + pt) * 128 + c4) = o;
  }
  u16* T = (u16*)smem;
  for (int tile = bid; tile < 128; tile += nb) {
    int pt0 = (tile & 7) * 64, h = (tile >> 3) & 3, b = tile >> 5;
    __syncthreads();
    for (int e = tid_; e < 2048; e += 256) {
      int pt = e >> 5, c4 = (e & 31) * 4;
      float4 v = *(const float4*)(p.in[3] + ((size_t)((b * 2 + l) * 512 + pt0 + pt) * 4 + h) * 128 + c4);
      const int a4 = (pt >> 2) & 3;
      const int pp = (pt & ~15) | ((((a4 & 1) << 1) | (a4 >> 1)) << 2) | (pt & 3);
      T[(c4 + 0) * 72 + pp] = f2bf(v.x); T[(c4 + 1) * 72 + pp] = f2bf(v.y);
      T[(c4 + 2) * 72 + pp] = f2bf(v.z); T[(c4 + 3) * 72 + pp] = f2bf(v.w);
    }
    __syncthreads();
    for (int e = tid_; e < 1024; e += 256) {
      int c = e >> 3, ch = e & 7;
      uint4 v = *(const uint4*)(T + c * 72 + ch * 8);
      *(uint4*)(VT + krow0(16 + b, h) * 128 + (size_t)c * 4608 + 4096 + pt0 + ch * 8) = v;
    }
  }
}

enum { EPI_IN = 0, EPI_RES1 = 1, EPI_SWIGLU = 2, EPI_RES2 = 3 };

template <int EPI>
__device__ __forceinline__ void gemm_epilogue(const Params& p, int l, int rowbase, int nt, f32x4 (&acc)[4][4]) {
  const int tid_ = otid();
  const int lane = tid_ & 63, wave = tid_ >> 6;
  const int wn = wave & 1, r = lane & 15, q = lane >> 4;
  const int m0 = rowbase;
  const int seq = tok_seq(m0);
  const int mv = seq_mv(seq);
  const float* modv = (const float*)(p.ws + OFF_MODV) + (size_t)(l * 5 + mv) * 6144;
  if (EPI == EPI_RES1 || EPI == EPI_RES2) {
    const float* gate = modv + (EPI == EPI_RES1 ? 2 : 5) * 1024;
    float4 x4[4][4], g4[4];
#pragma unroll
    for (int ns = 0; ns < 4; ++ns) g4[ns] = *(const float4*)(gate + nt * 128 + wn * 64 + ns * 16 + 4 * q);
#pragma unroll
    for (int ms = 0; ms < 4; ++ms) {
      const int t = m0 + ms * 16 + r;
      const float* xr = (EPI == EPI_RES1) ? xrow_ptr(p, l, t) : p.out + (size_t)t * DM;
#pragma unroll
      for (int ns = 0; ns < 4; ++ns) x4[ms][ns] = *(const float4*)(xr + nt * 128 + wn * 64 + ns * 16 + 4 * q);
    }
#pragma unroll
    for (int ms = 0; ms < 4; ++ms) {
      const int t = m0 + ms * 16 + r;
      float* xo = p.out + (size_t)t * DM;
#pragma unroll
      for (int ns = 0; ns < 4; ++ns) {
        const int col = nt * 128 + wn * 64 + ns * 16 + 4 * q;
        float4 o;
        o.x = x4[ms][ns].x + g4[ns].x * acc[ms][ns][0]; o.y = x4[ms][ns].y + g4[ns].y * acc[ms][ns][1];
        o.z = x4[ms][ns].z + g4[ns].z * acc[ms][ns][2]; o.w = x4[ms][ns].w + g4[ns].w * acc[ms][ns][3];
        *(float4*)(xo + col) = o;
      }
    }
  } else if (EPI == EPI_SWIGLU) {
    u16* H = (u16*)(p.ws);
#pragma unroll
    for (int ms = 0; ms < 4; ++ms) {
      const int t = m0 + ms * 16 + r;
#pragma unroll
      for (int pp = 0; pp < 2; ++pp) {
        const int col = nt * 64 + (wn * 2 + pp) * 16 + 4 * q;
        float hv[4];
#pragma unroll
        for (int i = 0; i < 4; ++i) hv[i] = siluf(acc[ms][2 * pp][i]) * acc[ms][2 * pp + 1][i];
        uint2 o; o.x = pack2(hv[0], hv[1]); o.y = pack2(hv[2], hv[3]);
        *(uint2*)(H + (size_t)t * FF + col) = o;
      }
    }
  } else {
    const bool latent = seq >= 16;
    const int tok0 = seq_tok0(seq);
    const float* bias = p.in[15] + l * INW;
    const float2* rope = (const float2*)(p.ws + OFF_ROPE);
#pragma unroll
    for (int ms = 0; ms < 4; ++ms)
#pragma unroll
      for (int ns = 0; ns < 4; ++ns) {
        int c = wn * 64 + ns * 16 + r;
        int ncol = nt * 128 + c;
        int sc = in_src_col(ncol);
        float bv = sc >= 0 ? bias[sc] : 0.f;
        float v[4];
#pragma unroll
        for (int i = 0; i < 4; ++i) v[i] = acc[ms][ns][i] + bv;
        int tb = m0 + ms * 16 + 4 * q;
        if (nt < 8) {
          int head = nt & 3;
          if (latent) {
            int d = c & 63, pi = d >> 1;
#pragma unroll
            for (int i = 0; i < 4; ++i) {
              float other = shx(v[i], 1, lane);
              int tl = tb + i - tok0;
              int pos = pi < 16 ? (tl >> 6) : (tl & 63);
              float2 cs = rope[pos * 16 + (pi & 15)];
              v[i] = (d & 1) ? (other * cs.y + v[i] * cs.x) : (v[i] * cs.x - other * cs.y);
            }
          }
          if (nt < 4) {
            u16* Q = (u16*)(p.ws + OFF_Q);
#pragma unroll
            for (int i = 0; i < 4; ++i) Q[(size_t)(tb + i) * 512 + head * 128 + c] = f2bf(v[i] * (0.125f * LOG2E));
          } else {
            u16* K = (u16*)(p.ws + OFF_K);
            size_t kr = krow0(seq, head) + (tb - tok0);
#pragma unroll
            for (int i = 0; i < 4; ++i) K[(kr + i) * 128 + c] = f2bf(v[i]);
            if (!latent) {
#pragma unroll
              for (int i = 0; i < 4; ++i)
                p.out[OUT_NK + ((size_t)((seq * 2 + l) * 256 + (tb + i - tok0)) * 4 + head) * 128 + c] = v[i];
            }
          }
        } else if (nt < 12) {
          int head = nt - 8;
          u16* VT = (u16*)(p.ws + OFF_VT);
          uint2 o; o.x = pack2(v[0], v[1]); o.y = pack2(v[2], v[3]);
          const int tl0 = tb - tok0;
          const int a4 = (tl0 >> 2) & 3;
          const int tperm = (tl0 & ~15) | ((((a4 & 1) << 1) | (a4 >> 1)) << 2);
          *(uint2*)(VT + krow0(seq, head) * 128 + (size_t)c * seq_lk(seq) + tperm) = o;
          if (!latent) {
#pragma unroll
            for (int i = 0; i < 4; ++i)
              p.out[OUT_NV + ((size_t)((seq * 2 + l) * 256 + (tb + i - tok0)) * 4 + head) * 128 + c] = v[i];
          }
        } else if (nt < 18) {
          u16* B = (u16*)(p.ws + OFF_BPRE);
#pragma unroll
          for (int i = 0; i < 4; ++i) B[(size_t)(tb + i) * 768 + (nt - 12) * 128 + c] = f2bf(v[i]);
        } else if (nt < 20) {
          u16* B = (u16*)(p.ws + OFF_BG);
#pragma unroll
          for (int i = 0; i < 4; ++i) B[(size_t)(tb + i) * 256 + (nt - 18) * 128 + c] = f2bf(v[i]);
        } else if (nt < 26) {
          u16* B = (u16*)(p.ws + OFF_CQKV);
          float s = (nt == 22 || nt == 23) ? 0.125f : 1.f;
#pragma unroll
          for (int i = 0; i < 4; ++i) B[(size_t)(tb + i) * 768 + (nt - 20) * 128 + c] = f2bf(v[i] * s);
        } else if (nt < 28) {
          u16* B = (u16*)(p.ws + OFF_CO);
#pragma unroll
          for (int i = 0; i < 4; ++i) B[(size_t)(tb + i) * 256 + (nt - 26) * 128 + c] = f2bf(v[i]);
        } else {
          if (c < 32) {
            float* G = (float*)(p.ws + OFF_GATE);
#pragma unroll
            for (int i = 0; i < 4; ++i) G[(size_t)(tb + i) * 32 + c] = v[i];
          }
        }
      }
  }
}

template <int EPI>
__device__ void gemm_tile(const Params& p, int l, const u16* A0, int lda0, const u16* A1, int lda1, int ksplit,
                          const u16* Bt, int K, int mt, int nt, char* smem) {
  const int tid = otid(), lane = tid & 63, wave = tid >> 6;
  const int wm = wave >> 1, wn = wave & 1, r = lane & 15, q = lane >> 4;
  const int nk = K / 64;
  f32x4 acc[4][4];
#pragma unroll
  for (int a = 0; a < 4; ++a)
#pragma unroll
    for (int b = 0; b < 4; ++b) acc[a][b] = (f32x4){0.f, 0.f, 0.f, 0.f};

  const int srow = wave * 8 + (lane >> 3);
  const unsigned kcb = (unsigned)(((lane & 7) ^ ((srow >> 1) & 7)) * 16);
  const unsigned ldst0 = (unsigned)(wave * 1024 + lane * 16);
  auto issue = [&](int kt, int buf) {
    char* sA = smem + buf * 32768 + ldst0;
    char* sB = sA + 16384;
    const int k0 = kt * 64;
    const char* Ab; unsigned lda2; unsigned ka;
    if (k0 < ksplit) { Ab = (const char*)(A0 + (size_t)mt * 128 * lda0); lda2 = (unsigned)lda0 * 2; ka = (unsigned)k0 * 2; }
    else { Ab = (const char*)(A1 + (size_t)mt * 128 * lda1); lda2 = (unsigned)lda1 * 2; ka = (unsigned)(k0 - ksplit) * 2; }
    const char* Bb = (const char*)(Bt + (size_t)nt * 128 * K);
    const unsigned ao = (unsigned)srow * lda2 + kcb + ka, bo = (unsigned)srow * (unsigned)(K * 2) + kcb + (unsigned)k0 * 2;
#pragma unroll
    for (int i = 0; i < 4; ++i) {
      glds16(Ab + (ao + (unsigned)i * 32u * lda2), sA + i * 4096);
      glds16(Bb + (bo + (unsigned)i * 32u * (unsigned)(K * 2)), sB + i * 4096);
    }
  };
  __syncthreads();
  issue(0, 0);
  for (int kt = 0; kt < nk; ++kt) {
    wait_vm0();
    __syncthreads();
    if (kt + 1 < nk) issue(kt + 1, (kt + 1) & 1);
    const char* sA = smem + (kt & 1) * 32768;
    const char* sB = sA + 16384;
    __builtin_amdgcn_iglp_opt(0);
#pragma unroll
    for (int s = 0; s < 2; ++s) {
      bf16x8 af[4], bfr[4];
#pragma unroll
      for (int ms = 0; ms < 4; ++ms) {
        int row = wm * 64 + ms * 16 + r;
        af[ms] = *(const bf16x8*)(sA + row * 128 + (((s * 4 + q) ^ ((row >> 1) & 7)) * 16));
      }
#pragma unroll
      for (int ns = 0; ns < 4; ++ns) {
        int row = wn * 64 + ns * 16 + r;
        bfr[ns] = *(const bf16x8*)(sB + row * 128 + (((s * 4 + q) ^ ((row >> 1) & 7)) * 16));
      }
#pragma unroll
      for (int ms = 0; ms < 4; ++ms)
#pragma unroll
        for (int ns = 0; ns < 4; ++ns)
          acc[ms][ns] = (EPI == EPI_IN) ? MFMA16(af[ms], bfr[ns], acc[ms][ns]) : MFMA16(bfr[ns], af[ms], acc[ms][ns]);
    }
  }
  gemm_epilogue<EPI>(p, l, mt * 128 + wm * 64, nt, acc);
}


__device__ __forceinline__ bool tile_map(int bid, int nb, int it, int ntm, int ntn, int& m, int& n) {
  if (nb != 512 || (ntm & 7)) {
    int t = bid + it * nb;
    if (t >= ntm * ntn) return false;
    m = t % ntm; n = t / ntm;
    return true;
  }
  const int x = bid & 7, j = bid >> 3, MX = ntm >> 3;
  int u = it * 64 + j;
  const int fullp = ntn >> 3;
  int np, wp;
  if (u < fullp * 8 * MX) { np = u / (8 * MX); u -= np * 8 * MX; wp = 8; }
  else { np = fullp; u -= fullp * 8 * MX; wp = ntn & 7; if (u >= wp * MX) return false; }
  m = x * MX + u / wp;
  n = np * 8 + u % wp;
  return true;
}

template <int EPI>
__device__ void gemm_phase(const Params& p, int l, const u16* A0, int lda0, const u16* A1, int lda1, int ksplit,
                           const u16* Bt, int K, int ntn, char* smem, int bid, int nb) {
  const int ntm = NT / 128;
  int m, n;
  for (int it = 0; tile_map(bid, nb, it, ntm, ntn, m, n); ++it) gemm_tile<EPI>(p, l, A0, lda0, A1, lda1, ksplit, Bt, K, m, n, smem);
}


template <int EPI>
__device__ void gemm_tile_big(const Params& p, int l, const u16* A, int lda, const u16* Bt, int K, int mt, int nt, char* smem) {
  const int tid = otid(), lane = tid & 63, wave = tid >> 6;
  const int wm = wave >> 1, wn = wave & 1, r = lane & 15, q = lane >> 4;
  const int nk = K / 32;
  f32x4 acc[2][4][4];
#pragma unroll
  for (int hf = 0; hf < 2; ++hf)
#pragma unroll
    for (int a = 0; a < 4; ++a)
#pragma unroll
      for (int b = 0; b < 4; ++b) acc[hf][a][b] = (f32x4){0.f, 0.f, 0.f, 0.f};
  const int srow = wave * 16 + (lane >> 2);
  const unsigned kcb = (unsigned)(((lane & 3) ^ ((srow >> 2) & 3)) * 16);
  const unsigned ldst0 = (unsigned)(wave * 1024 + lane * 16);
  const char* Ab = (const char*)(A + (size_t)mt * 256 * lda);
  const char* Bb = (const char*)(Bt + (size_t)nt * 128 * K);
  const unsigned lda2 = (unsigned)lda * 2, ldb2 = (unsigned)K * 2;
  auto issue = [&](int kt, int buf) {
    char* sA = smem + buf * 24576 + ldst0;
    char* sB = sA + 16384;
    const unsigned ao = (unsigned)srow * lda2 + kcb + (unsigned)kt * 64u, bo = (unsigned)srow * ldb2 + kcb + (unsigned)kt * 64u;
#pragma unroll
    for (int i = 0; i < 4; ++i) glds16(Ab + (ao + (unsigned)i * 64u * lda2), sA + i * 4096);
#pragma unroll
    for (int i = 0; i < 2; ++i) glds16(Bb + (bo + (unsigned)i * 64u * ldb2), sB + i * 4096);
  };
  __syncthreads();
  issue(0, 0);
  issue(1, 1);
  int stg = 0;
  for (int kt = 0; kt < nk; ++kt) {
    if (kt + 1 < nk) asm volatile("s_waitcnt vmcnt(6)" ::: "memory");
    else asm volatile("s_waitcnt vmcnt(0)" ::: "memory");
    __builtin_amdgcn_s_barrier();
    if (kt + 2 < nk) issue(kt + 2, stg >= 1 ? stg - 1 : 2);
    const unsigned bo = (unsigned)stg * 24576u;
    stg = stg == 2 ? 0 : stg + 1;
    __builtin_amdgcn_iglp_opt(0);
    bf16x8 bfr[4];
#pragma unroll
    for (int ns = 0; ns < 4; ++ns) {
      int row = wn * 64 + ns * 16 + r;
      bfr[ns] = *(const bf16x8*)(smem + bo + 16384u + (unsigned)row * 64u + (unsigned)((q ^ ((row >> 2) & 3)) * 16));
    }
#pragma unroll
    for (int hf = 0; hf < 2; ++hf) {
      bf16x8 af[4];
#pragma unroll
      for (int ms = 0; ms < 4; ++ms) {
        int row = wm * 128 + hf * 64 + ms * 16 + r;
        af[ms] = *(const bf16x8*)(smem + bo + (unsigned)row * 64u + (unsigned)((q ^ ((row >> 2) & 3)) * 16));
      }
#pragma unroll
      for (int ms = 0; ms < 4; ++ms)
#pragma unroll
        for (int ns = 0; ns < 4; ++ns) acc[hf][ms][ns] = MFMA16(bfr[ns], af[ms], acc[hf][ms][ns]);
    }
  }
  gemm_epilogue<EPI>(p, l, mt * 256 + wm * 128, nt, acc[0]);
  gemm_epilogue<EPI>(p, l, mt * 256 + wm * 128 + 64, nt, acc[1]);
}

template <int EPI>
__device__ void gemm_phase_big(const Params& p, int l, const u16* A, int lda, const u16* Bt, int K, int ntn, char* smem, int bid, int nb) {
  const int ntm = NT / 256;
  int m, n;
  for (int it = 0; tile_map(bid, nb, it, ntm, ntn, m, n); ++it) gemm_tile_big<EPI>(p, l, A, lda, Bt, K, m, n, smem);
}

__device__ void prep_item(const Params& p, int l, int ci, int h, char* smem) {
  const int tid = otid(), lane = tid & 63, wave = tid >> 6;
  float* qs = (float*)smem;
  float* ks = qs + 64 * 65;
  float* As = (float*)smem;
  float* gcs = (float*)(smem + 33280);
  float* bes = gcs + 128;
  const int t0 = ci * 64;
  const int seq = tok_seq(t0);
  const int stok0 = seq_tok0(seq), slen = seq_len(seq);
  const int ti = tid >> 4, tj = tid & 15;
  const int item = ci * 4 + h;
  __syncthreads();
  {
    const u16* C = (const u16*)(p.ws + OFF_CQKV);
    for (int e = tid; e < 1024; e += 256) {
      int t = (e >> 3) & 63, ch = e & 7, isk = e >> 9;
      uint4 v = *(const uint4*)(C + (size_t)(t0 + t) * 768 + isk * 256 + h * 64 + ch * 8);
      float* dst = (isk ? ks : qs) + t * 65 + ch * 8;
      dst[0] = bf2f(v.x & 0xffff); dst[1] = bf2f(v.x >> 16); dst[2] = bf2f(v.y & 0xffff); dst[3] = bf2f(v.y >> 16);
      dst[4] = bf2f(v.z & 0xffff); dst[5] = bf2f(v.z >> 16); dst[6] = bf2f(v.w & 0xffff); dst[7] = bf2f(v.w >> 16);
    }
    if (wave < 2) {
      const int dir = wave, i = lane;
      const int t = t0 + (dir ? 63 - i : i);
      const float* G = (const float*)(p.ws + OFF_GATE) + (size_t)t * 32 + dir * 4 + h;
      float ba = G[0], bb = G[8], ig = G[16], cf = G[24] + p.in[23][l * 8 + dir * 4 + h];
      float lf = fminf(cf, 0.f) - log1pf(__expf(-fabsf(cf)));
      float g = -__expf(p.in[20][l * 8 + dir * 4 + h]) * softplusf(ba + p.in[21][l * 8 + dir * 4 + h]);
      float be = sigmf(bb);
      float b = lf, gc = g;
#pragma unroll
      for (int o = 1; o < 64; o <<= 1) {
        float tb = shl_(b, (lane - o) & 63), tg = shl_(gc, (lane - o) & 63);
        if (lane >= o) { b += tb; gc += tg; }
      }
      float a = ig - b, pm = a;
#pragma unroll
      for (int o = 1; o < 64; o <<= 1) {
        float tp = shl_(pm, (lane - o) & 63);
        if (lane >= o) pm = fmaxf(pm, tp);
      }
      float* maux = (float*)(p.ws + OFF_MAUX) + (size_t)(item * 2 + dir) * 192;
      maux[i] = b; maux[64 + i] = a; maux[128 + i] = pm;
      float* daux = (float*)(p.ws + OFF_DAUX) + (size_t)(item * 2 + dir) * 128;
      daux[i] = gc; daux[64 + i] = be;
      gcs[dir * 64 + i] = gc; bes[dir * 64 + i] = be;
    }
    __syncthreads();
    float acc[4][4];
#pragma unroll
    for (int a = 0; a < 4; ++a)
#pragma unroll
      for (int b = 0; b < 4; ++b) acc[a][b] = 0.f;
    for (int d = 0; d < 64; ++d) {
      float x[4], y[4];
#pragma unroll
      for (int a = 0; a < 4; ++a) { x[a] = qs[(4 * ti + a) * 65 + d]; y[a] = ks[(4 * tj + a) * 65 + d]; }
#pragma unroll
      for (int a = 0; a < 4; ++a)
#pragma unroll
        for (int b = 0; b < 4; ++b) acc[a][b] += x[a] * y[b];
    }
    u16* MQK = (u16*)(p.ws + OFF_MQK) + (size_t)item * 4096;
#pragma unroll
    for (int a = 0; a < 4; ++a) {
      uint2 o; o.x = pack2(acc[a][0], acc[a][1]); o.y = pack2(acc[a][2], acc[a][3]);
      *(uint2*)(MQK + (4 * ti + a) * 64 + 4 * tj) = o;
    }
    __syncthreads();
  }
  {
    const u16* B = (const u16*)(p.ws + OFF_BPRE);
    const float* cw = p.in[19] + l * 5 * 768;
    u16* DQ = (u16*)(p.ws + OFF_DQKV) + (size_t)item * 3 * 4096;
    float* xs = (float*)(smem + 34304);
#pragma unroll 1
    for (int part = 0; part < 3; ++part) {
      int ch = part * 256 + h * 64 + lane;
      float w0 = cw[ch], w1 = cw[768 + ch], w2 = cw[2 * 768 + ch], w3 = cw[3 * 768 + ch], w4 = cw[4 * 768 + ch];
      __syncthreads();
      for (int e = tid; e < 544; e += 256) {
        int rr = e >> 3, c8 = e & 7;
        int tl = (t0 - stok0) + rr - 2;
        uint4 v = make_uint4(0u, 0u, 0u, 0u);
        if (tl >= 0 && tl < slen) v = *(const uint4*)(B + (size_t)(stok0 + tl) * 768 + part * 256 + h * 64 + c8 * 8);
        float* dst = xs + rr * 64 + c8 * 8;
        dst[0] = bf2f(v.x & 0xffff); dst[1] = bf2f(v.x >> 16); dst[2] = bf2f(v.y & 0xffff); dst[3] = bf2f(v.y >> 16);
        dst[4] = bf2f(v.z & 0xffff); dst[5] = bf2f(v.z >> 16); dst[6] = bf2f(v.w & 0xffff); dst[7] = bf2f(v.w >> 16);
      }
      __syncthreads();
#pragma unroll 4
      for (int i = 0; i < 16; ++i) {
        int t = wave + 4 * i;
        const float* xr = xs + t * 64 + lane;
        float v = siluf(w0 * xr[0] + w1 * xr[64] + w2 * xr[128] + w3 * xr[192] + w4 * xr[256]);
        if (part < 2) {
          float ss = wave_sum(v * v, lane);
          v *= rsqrtf(ss + EPSF);
          if (part == 0) { v *= 0.125f; qs[t * 65 + lane] = v; } else ks[t * 65 + lane] = v;
        }
        DQ[part * 4096 + t * 64 + lane] = f2bf(v);
      }
    }
    __syncthreads();
  }
  float gk[4][4], qk[4][4];
#pragma unroll
  for (int a = 0; a < 4; ++a)
#pragma unroll
    for (int b = 0; b < 4; ++b) { gk[a][b] = 0.f; qk[a][b] = 0.f; }
  for (int d = 0; d < 64; ++d) {
    float x[4], y[4], z[4];
#pragma unroll
    for (int a = 0; a < 4; ++a) { x[a] = qs[(4 * ti + a) * 65 + d]; z[a] = ks[(4 * ti + a) * 65 + d]; y[a] = ks[(4 * tj + a) * 65 + d]; }
#pragma unroll
    for (int a = 0; a < 4; ++a)
#pragma unroll
      for (int b = 0; b < 4; ++b) { qk[a][b] += x[a] * y[b]; gk[a][b] += z[a] * y[b]; }
  }
  __syncthreads();
  u16* PR1 = (u16*)(p.ws + OFF_U);
#pragma unroll
  for (int dir = 0; dir < 2; ++dir) {
    u16* AQ = PR1 + ((size_t)(item * 2 + dir) * 2 + 1) * 4096;
#pragma unroll
    for (int a = 0; a < 4; ++a) {
      int ir = 4 * ti + a;
      int ip = dir ? 63 - ir : ir;
      float gi = gcs[dir * 64 + ip], bi = bes[dir * 64 + ip];
#pragma unroll
      for (int b = 0; b < 4; ++b) {
        int jr = 4 * tj + b;
        int jp = dir ? 63 - jr : jr;
        float e = __expf(gi - gcs[dir * 64 + jp]);
        float akk = (jp < ip) ? bi * gk[a][b] * e : 0.f;
        float aqk = (jp <= ip) ? qk[a][b] * e : 0.f;
        As[(dir * 64 + ip) * 64 + jp] = akk;
        AQ[ip * 64 + jp] = f2bf(aqk);
      }
    }
  }
  __syncthreads();
  if (wave < 2) {
    const float* A = As + wave * 4096;
    u16* T = PR1 + ((size_t)(item * 2 + wave) * 2 + 0) * 4096;
    float tc[64];
#pragma unroll
    for (int i = 0; i < 64; ++i) {
      float acc = (i == lane) ? 1.f : 0.f;
#pragma unroll
      for (int j4 = 0; j4 < (i + 3) / 4; ++j4) {
        float4 a = *(const float4*)(A + i * 64 + j4 * 4);
        if (j4 * 4 + 0 < i) acc -= a.x * tc[j4 * 4 + 0];
        if (j4 * 4 + 1 < i) acc -= a.y * tc[j4 * 4 + 1];
        if (j4 * 4 + 2 < i) acc -= a.z * tc[j4 * 4 + 2];
        if (j4 * 4 + 3 < i) acc -= a.w * tc[j4 * 4 + 3];
      }
      tc[i] = acc;
      T[i * 64 + lane] = f2bf(acc);
    }
  }
}

constexpr int SROW = 136;
constexpr int SIMG = 64 * SROW;

__device__ __forceinline__ bf16x8 frag_perm(const char* img, int row, int s, int q) {
  const char* b = img + row * SROW + s * 64 + q * 8;
  s16x4 lo = *(const s16x4*)(b), hi = *(const s16x4*)(b + 32);
  return (bf16x8){lo[0], lo[1], lo[2], lo[3], hi[0], hi[1], hi[2], hi[3]};
}
__device__ __forceinline__ bf16x8 frag_nat(const char* img, int row, int s, int q) {
  const char* b = img + row * SROW + s * 64 + q * 16;
  s16x4 lo = *(const s16x4*)(b), hi = *(const s16x4*)(b + 8);
  return (bf16x8){lo[0], lo[1], lo[2], lo[3], hi[0], hi[1], hi[2], hi[3]};
}
typedef __attribute__((ext_vector_type(4))) unsigned u32x4_t;
__device__ __forceinline__ bf16x8 acc_frag(const f32x4& x0, const f32x4& x1) {
  u32x4_t w = {pack2(x0[0], x0[1]), pack2(x0[2], x0[3]), pack2(x1[0], x1[1]), pack2(x1[2], x1[3])};
  return __builtin_bit_cast(bf16x8, w);
}
__device__ __forceinline__ uint4 img_ld(const u16* g, int gstride, int tid, int i) {
  int e = tid + 256 * i;
  return *(const uint4*)(g + (size_t)(e >> 3) * gstride + (e & 7) * 8);
}
__device__ __forceinline__ void img_st(char* img, uint4 v, int tid, int i, bool rev_rows, bool rev_cols) {
  int e = tid + 256 * i;
  int row = e >> 3, ch = e & 7;
  int drow = rev_rows ? 63 - row : row;
  if (rev_cols) {
    uint4 w;
    w.x = (v.w >> 16) | (v.w << 16); w.y = (v.z >> 16) | (v.z << 16);
    w.z = (v.y >> 16) | (v.y << 16); w.w = (v.x >> 16) | (v.x << 16);
    v = w; ch = 7 - ch;
  }
  char* d = img + drow * SROW + ch * 16;
  *(uint2*)d = make_uint2(v.x, v.y);
  *(uint2*)(d + 8) = make_uint2(v.z, v.w);
}
__device__ __forceinline__ uint4 imgt_ld(const u16* g, int gstride, int tid, int i) {
  int e = tid + 256 * i;
  return *(const uint4*)(g + (size_t)(e & 63) * gstride + (e >> 6) * 8);
}
__device__ __forceinline__ void imgt_st(char* img, uint4 v, int tid, int i, bool rev_rows) {
  int e = tid + 256 * i;
  int row = e & 63, ch = e >> 6;
  int ip = rev_rows ? 63 - row : row;
  unsigned w[4] = {v.x, v.y, v.z, v.w};
#pragma unroll
  for (int j = 0; j < 4; ++j) {
    *(u16*)(img + (ch * 8 + 2 * j) * SROW + ip * 2) = (u16)(w[j] & 0xffffu);
    *(u16*)(img + (ch * 8 + 2 * j + 1) * SROW + ip * 2) = (u16)(w[j] >> 16);
  }
}

__device__ void delta_scan(const Params& p, int l, int seq, int h, int dir, char* smem) {
  const int tid = otid(), lane = tid & 63, wave = tid >> 6;
  const int r = lane & 15, q = lane >> 4;
  char* iK = smem;
  char* iKT = smem + SIMG;
  char* iQ = smem + 2 * SIMG;
  char* iT = smem + 3 * SIMG;
  char* iA = smem + 4 * SIMG;
  char* iV = smem + 5 * SIMG;
  float* sgc = (float*)(smem + 6 * SIMG);
  float* sbe = sgc + 64;
  float* seg = sgc + 128;
  float* skd = sgc + 192;
  const int nch = seq_len(seq) / 64;
  const int ci0 = seq_tok0(seq) / 64;
  const int dvc = wave * 16 + r;
  f32x4 S[4];
  if (seq >= 16) {
    const float* s0 = p.in[4] + ((size_t)(((seq - 16) * 2 + l) * 2 + dir) * 4 + h) * 4096;
#pragma unroll
    for (int t = 0; t < 4; ++t)
#pragma unroll
      for (int i = 0; i < 4; ++i) S[t][i] = s0[(16 * t + 4 * q + i) * 64 + dvc];
  } else {
#pragma unroll
    for (int t = 0; t < 4; ++t) S[t] = (f32x4){0.f, 0.f, 0.f, 0.f};
  }
  u16* O = (u16*)(p.ws + OFF_BPRE) + (size_t)dir * NT * 256;
  uint4 pre[12];
  float preaux = 0.f;
  auto load_chunk = [&](int n) {
    const int cix = ci0 + (dir ? nch - 1 - n : n);
    const int itm = cix * 4 + h;
    const u16* DQ = (const u16*)(p.ws + OFF_DQKV) + (size_t)itm * 3 * 4096;
    const u16* PR = (const u16*)(p.ws + OFF_U) + (size_t)(itm * 2 + dir) * 2 * 4096;
    const float* aux = (const float*)(p.ws + OFF_DAUX) + (size_t)(itm * 2 + dir) * 128;
#pragma unroll
    for (int i = 0; i < 2; ++i) {
      pre[i] = img_ld(DQ, 64, tid, i);
      pre[2 + i] = img_ld(DQ + 4096, 64, tid, i);
      pre[4 + i] = imgt_ld(DQ + 4096, 64, tid, i);
      pre[6 + i] = imgt_ld(DQ + 8192, 64, tid, i);
      pre[8 + i] = img_ld(PR, 64, tid, i);
      pre[10 + i] = img_ld(PR + 4096, 64, tid, i);
    }
    if (tid < 128) preaux = aux[tid];
  };
  load_chunk(0);
  for (int n = 0; n < nch; ++n) {
    const int ci = ci0 + (dir ? nch - 1 - n : n);
    __syncthreads();
#pragma unroll
    for (int i = 0; i < 2; ++i) {
      img_st(iQ, pre[i], tid, i, dir, false);
      img_st(iK, pre[2 + i], tid, i, dir, false);
      imgt_st(iKT, pre[4 + i], tid, i, dir);
      imgt_st(iV, pre[6 + i], tid, i, dir);
      img_st(iT, pre[8 + i], tid, i, false, false);
      img_st(iA, pre[10 + i], tid, i, false, false);
    }
    if (tid < 128) sgc[tid] = preaux;
    if (tid < 64) {
      float glast = __int_as_float(__builtin_amdgcn_readlane(__float_as_int(preaux), 63));
      seg[tid] = __expf(preaux);
      skd[tid] = __expf(glast - preaux);
    }
    __syncthreads();
    if (n + 1 < nch) load_chunk(n + 1);
    const float gl = sgc[63];
    bf16x8 fK[4][2], fQ[4][2], fT[4][2];
    float4 eg4[4], be4[4], kd4[4];
    float vv[4][4];
#pragma unroll
    for (int m = 0; m < 4; ++m) {
      const int row = 16 * m + r;
      fK[m][0] = frag_perm(iK, row, 0, q); fK[m][1] = frag_perm(iK, row, 1, q);
      fQ[m][0] = frag_perm(iQ, row, 0, q); fQ[m][1] = frag_perm(iQ, row, 1, q);
      fT[m][0] = frag_perm(iT, row, 0, q); fT[m][1] = frag_perm(iT, row, 1, q);
      eg4[m] = *(const float4*)(seg + 16 * m + 4 * q);
      be4[m] = *(const float4*)(sbe + 16 * m + 4 * q);
      kd4[m] = *(const float4*)(skd + 16 * m + 4 * q);
      const s16x4 v4 = *(const s16x4*)(iV + dvc * SROW + (16 * m + 4 * q) * 2);
#pragma unroll
      for (int i = 0; i < 4; ++i) vv[m][i] = bf2f((u16)v4[i]);
    }
    bf16x8 sb0 = acc_frag(S[0], S[1]), sb1 = acc_frag(S[2], S[3]);
    f32x4 rr[4], qs_[4];
#pragma unroll
    for (int m = 0; m < 4; ++m) {
      f32x4 m1 = (f32x4){0.f, 0.f, 0.f, 0.f}, qq = m1;
      m1 = MFMA16(fK[m][0], sb0, m1); m1 = MFMA16(fK[m][1], sb1, m1);
      qq = MFMA16(fQ[m][0], sb0, qq); qq = MFMA16(fQ[m][1], sb1, qq);
      const float eg[4] = {eg4[m].x, eg4[m].y, eg4[m].z, eg4[m].w}, be[4] = {be4[m].x, be4[m].y, be4[m].z, be4[m].w};
#pragma unroll
      for (int i = 0; i < 4; ++i) {
        rr[m][i] = be[i] * (vv[m][i] - eg[i] * m1[i]);
        qs_[m][i] = eg[i] * qq[i];
      }
    }
    bf16x8 fA[4][2], fKT[4][2];
#pragma unroll
    for (int m = 0; m < 4; ++m) {
      const int row = 16 * m + r;
      fA[m][0] = frag_perm(iA, row, 0, q); fA[m][1] = frag_perm(iA, row, 1, q);
      fKT[m][0] = frag_perm(iKT, row, 0, q); fKT[m][1] = frag_perm(iKT, row, 1, q);
    }
    bf16x8 rb0 = acc_frag(rr[0], rr[1]), rb1 = acc_frag(rr[2], rr[3]);
    f32x4 vn[4];
#pragma unroll
    for (int m = 0; m < 4; ++m) {
      f32x4 a = (f32x4){0.f, 0.f, 0.f, 0.f};
      a = MFMA16(fT[m][0], rb0, a); a = MFMA16(fT[m][1], rb1, a);
      vn[m] = a;
    }
    bf16x8 vb0 = acc_frag(vn[0], vn[1]), vb1 = acc_frag(vn[2], vn[3]);
#pragma unroll
    for (int m = 0; m < 4; ++m) {
      f32x4 o = qs_[m];
      o = MFMA16(fA[m][0], vb0, o); o = MFMA16(fA[m][1], vb1, o);
      const float kd[4] = {kd4[m].x, kd4[m].y, kd4[m].z, kd4[m].w};
#pragma unroll
      for (int i = 0; i < 4; ++i) {
        int tr = 16 * m + 4 * q + i;
        int tg = ci * 64 + (dir ? 63 - tr : tr);
        O[(size_t)tg * 256 + h * 64 + dvc] = f2bf(o[i]);
        vn[m][i] *= kd[i];
      }
    }
    bf16x8 vd0 = acc_frag(vn[0], vn[1]), vd1 = acc_frag(vn[2], vn[3]);
    const float egl = __expf(gl);
#pragma unroll
    for (int t = 0; t < 4; ++t) {
      f32x4 a = S[t] * egl;
      a = MFMA16(fKT[t][0], vd0, a); a = MFMA16(fKT[t][1], vd1, a);
      S[t] = a;
    }
  }
  if (seq < 16) {
    float* o = p.out + OUT_DS + ((size_t)((seq * 2 + l) * 2 + dir) * 4 + h) * 4096;
#pragma unroll
    for (int t = 0; t < 4; ++t)
#pragma unroll
      for (int i = 0; i < 4; ++i) o[(16 * t + 4 * q + i) * 64 + dvc] = S[t][i];
  }
}

__device__ void mlstm_scan(const Params& p, int l, int seq, int h, int dir, char* smem) {
  const int tid = otid(), lane = tid & 63, wave = tid >> 6;
  const int r = lane & 15, q = lane >> 4;
  char* iQ = smem;
  char* iQK = smem + SIMG;
  char* iKT = smem + 2 * SIMG;
  char* iVT = smem + 3 * SIMG;
  float* sb = (float*)(smem + 4 * SIMG);
  float* sa = sb + 64;
  float* spm = sb + 128;
  float* sea = sb + 192;
  float* rw = sb + 256 + (otid() >> 6) * 256;
  const int nch = seq_len(seq) / 64;
  const int ci0 = seq_tok0(seq) / 64;
  const int dvc = wave * 16 + r;
  f32x4 C[4], N[4];
  float ms;
  if (seq >= 16) {
    size_t sidx = (size_t)(((seq - 16) * 2 + l) * 2 + dir) * 4 + h;
    const float* c0 = p.in[5] + sidx * 4096;
    const float* n0 = p.in[6] + sidx * 64;
    ms = p.in[7][sidx];
#pragma unroll
    for (int t = 0; t < 4; ++t)
#pragma unroll
      for (int i = 0; i < 4; ++i) {
        C[t][i] = c0[(16 * t + 4 * q + i) * 64 + dvc];
        N[t][i] = (r == 0) ? n0[16 * t + 4 * q + i] : 0.f;
      }
  } else {
    ms = 0.f;
#pragma unroll
    for (int t = 0; t < 4; ++t) { C[t] = (f32x4){0.f, 0.f, 0.f, 0.f}; N[t] = C[t]; }
  }
  const short one_bf = (r == 0) ? (short)0x3f80 : (short)0;
  const bf16x8 ones = (bf16x8){one_bf, one_bf, one_bf, one_bf, one_bf, one_bf, one_bf, one_bf};
  u16* O = (u16*)(p.ws + OFF_MOM) + (size_t)dir * NT * 256;
  const u16* CQ = (const u16*)(p.ws + OFF_CQKV);
  uint4 pre[8];
  float preaux = 0.f;
  auto load_chunk = [&](int n) {
    const int cix = ci0 + (dir ? nch - 1 - n : n);
    const int itm = cix * 4 + h;
    const float* aux = (const float*)(p.ws + OFF_MAUX) + (size_t)(itm * 2 + dir) * 192;
    const u16* cq = CQ + (size_t)cix * 64 * 768 + h * 64;
#pragma unroll
    for (int i = 0; i < 2; ++i) {
      pre[i] = img_ld(cq, 768, tid, i);
      pre[2 + i] = img_ld((const u16*)(p.ws + OFF_MQK) + (size_t)itm * 4096, 64, tid, i);
      pre[4 + i] = imgt_ld(cq + 256, 768, tid, i);
      pre[6 + i] = imgt_ld(cq + 512, 768, tid, i);
    }
    if (tid < 192) preaux = aux[tid];
  };
  load_chunk(0);
  for (int n = 0; n < nch; ++n) {
    const int ci = ci0 + (dir ? nch - 1 - n : n);
    __syncthreads();
#pragma unroll
    for (int i = 0; i < 2; ++i) {
      img_st(iQ, pre[i], tid, i, dir, false);
      img_st(iQK, pre[2 + i], tid, i, dir, dir);
      imgt_st(iKT, pre[4 + i], tid, i, dir);
      imgt_st(iVT, pre[6 + i], tid, i, dir);
    }
    if (tid < 192) sb[tid] = preaux;
    if (tid >= 64 && tid < 128) sea[tid - 64] = __expf(preaux);
    __syncthreads();
    if (n + 1 < nch) load_chunk(n + 1);
    const float blast = sb[63], pmlast = spm[63];
    {
      float brow = sb[lane];
      float mtl = fmaxf(brow + ms, brow + spm[lane]);
      rw[lane] = __expf(brow + ms - mtl);
      rw[64 + lane] = __expf(-mtl);
      rw[128 + lane] = __expf(brow - mtl);
    }
    __builtin_amdgcn_wave_barrier();
    float cf[2][8];
#pragma unroll
    for (int s2 = 0; s2 < 2; ++s2) {
      float4 c0 = *(const float4*)(sea + 32 * s2 + 8 * q), c1 = *(const float4*)(sea + 32 * s2 + 8 * q + 4);
      cf[s2][0] = c0.x; cf[s2][1] = c0.y; cf[s2][2] = c0.z; cf[s2][3] = c0.w;
      cf[s2][4] = c1.x; cf[s2][5] = c1.y; cf[s2][6] = c1.z; cf[s2][7] = c1.w;
    }
    bf16x8 cb0 = acc_frag(C[0], C[1]), cb1 = acc_frag(C[2], C[3]);
    bf16x8 nb0 = acc_frag(N[0], N[1]), nb1 = acc_frag(N[2], N[3]);
    bf16x8 vf0 = frag_nat(iVT, dvc, 0, q), vf1 = frag_nat(iVT, dvc, 1, q);
#pragma unroll
    for (int m = 0; m < 4; ++m) {
      int row = 16 * m + r;
      f32x4 qc = (f32x4){0.f, 0.f, 0.f, 0.f}, qn = qc;
      bf16x8 a0 = frag_perm(iQ, row, 0, q), a1 = frag_perm(iQ, row, 1, q);
      qc = MFMA16(a0, cb0, qc); qc = MFMA16(a1, cb1, qc);
      qn = MFMA16(a0, nb0, qn); qn = MFMA16(a1, nb1, qn);
      const float rfA = rw[128 + row];
      bf16x8 sf[2];
#pragma unroll
      for (int s2 = 0; s2 < 2; ++s2) {
        bf16x8 qkf = frag_nat(iQK, row, s2, q);
        float e[8];
#pragma unroll
        for (int j = 0; j < 8; ++j) {
          int jp = 32 * s2 + 8 * q + j;
          e[j] = (jp <= row) ? bf2f((u16)qkf[j]) * rfA * cf[s2][j] : 0.f;
        }
        u32x4_t w = {pack2(e[0], e[1]), pack2(e[2], e[3]), pack2(e[4], e[5]), pack2(e[6], e[7])};
        sf[s2] = __builtin_bit_cast(bf16x8, w);
      }
      const float4 wi4 = *(const float4*)(rw + 16 * m + 4 * q);
      const float4 em4 = *(const float4*)(rw + 64 + 16 * m + 4 * q);
      const float wi[4] = {wi4.x, wi4.y, wi4.z, wi4.w}, em[4] = {em4.x, em4.y, em4.z, em4.w};
      f32x4 num, den;
#pragma unroll
      for (int i = 0; i < 4; ++i) { num[i] = wi[i] * qc[i]; den[i] = wi[i] * qn[i]; }
      num = MFMA16(sf[0], vf0, num); num = MFMA16(sf[1], vf1, num);
      den = MFMA16(sf[0], ones, den); den = MFMA16(sf[1], ones, den);
#pragma unroll
      for (int i = 0; i < 4; ++i) {
        int tr = 16 * m + 4 * q + i;
        float dr = shl_(den[i], q * 16);
        float hv = num[i] * __builtin_amdgcn_rcpf(fmaxf(fabsf(dr), em[i]));
        int tg = ci * 64 + (dir ? 63 - tr : tr);
        O[(size_t)tg * 256 + h * 64 + dvc] = f2bf(hv);
      }
    }
    float mnew = fmaxf(blast + ms, blast + pmlast);
    float dec = __expf(blast + ms - mnew);
    const float ebl = __expf(blast - mnew);
    bf16x8 wv[2], wo[2];
#pragma unroll
    for (int s2 = 0; s2 < 2; ++s2) {
      bf16x8 vf = s2 ? vf1 : vf0;
      float wk[8], wvv[8];
#pragma unroll
      for (int j = 0; j < 8; ++j) { wk[j] = ebl * cf[s2][j]; wvv[j] = wk[j] * bf2f((u16)vf[j]); }
      u32x4_t w1 = {pack2(wvv[0], wvv[1]), pack2(wvv[2], wvv[3]), pack2(wvv[4], wvv[5]), pack2(wvv[6], wvv[7])};
      u32x4_t w2 = {pack2(wk[0], wk[1]), pack2(wk[2], wk[3]), pack2(wk[4], wk[5]), pack2(wk[6], wk[7])};
      if (r != 0) w2 = (u32x4_t){0u, 0u, 0u, 0u};
      wv[s2] = __builtin_bit_cast(bf16x8, w1);
      wo[s2] = __builtin_bit_cast(bf16x8, w2);
    }
#pragma unroll
    for (int t = 0; t < 4; ++t) {
      int row = 16 * t + r;
      bf16x8 k0 = frag_nat(iKT, row, 0, q), k1 = frag_nat(iKT, row, 1, q);
      f32x4 c = C[t] * dec, nn = N[t] * dec;
      c = MFMA16(k0, wv[0], c); c = MFMA16(k1, wv[1], c);
      nn = MFMA16(k0, wo[0], nn); nn = MFMA16(k1, wo[1], nn);
      C[t] = c; N[t] = nn;
    }
    __builtin_amdgcn_wave_barrier();
    ms = mnew;
  }
  if (seq < 16) {
    size_t sidx = (size_t)((seq * 2 + l) * 2 + dir) * 4 + h;
    float* oc = p.out + OUT_MC + sidx * 4096;
#pragma unroll
    for (int t = 0; t < 4; ++t)
#pragma unroll
      for (int i = 0; i < 4; ++i) oc[(16 * t + 4 * q + i) * 64 + dvc] = C[t][i];
    if (wave == 0 && r == 0) {
#pragma unroll
      for (int t = 0; t < 4; ++t)
#pragma unroll
        for (int i = 0; i < 4; ++i) p.out[OUT_MN + sidx * 64 + 16 * t + 4 * q + i] = N[t][i];
    }
    if (tid == 0) p.out[OUT_MM + sidx] = ms;
  }
}

__device__ void attn_item(const Params& p, int l, int seq, int head, int qb, char* smem) {
  const int tid = otid(), lane = tid & 63, wave = tid >> 6;
  const int r32 = lane & 31, hh = lane >> 5;
  const int qg = wave >> 1, c = wave & 1;
  const int Lk = seq_lk(seq);
  const int ntile = Lk / 64;
  const size_t kr0 = krow0(seq, head);
  const u16* Kb = (const u16*)(p.ws + OFF_K) + kr0 * 128;
  const u16* Vb = (const u16*)(p.ws + OFF_VT) + kr0 * 128;
  u16* Q = (u16*)(p.ws + OFF_Q);
  const int tq = seq_tok0(seq) + qb * 64 + qg * 32 + r32;
  bf16x8 qf[4];
#pragma unroll
  for (int ks = 0; ks < 4; ++ks) qf[ks] = *(const bf16x8*)(Q + (size_t)tq * 512 + head * 128 + c * 64 + ks * 16 + hh * 8);
  f32x16 O[4];
#pragma unroll
  for (int d = 0; d < 4; ++d)
#pragma unroll
    for (int i = 0; i < 16; ++i) O[d][i] = 0.f;
  float mrun = -1.0e30f, lrun = 0.f;

  const unsigned koff0 = (unsigned)((wave * 4 + (lane >> 4)) * 256 + (((lane & 15) ^ ((wave * 4 + (lane >> 4)) & 15)) * 16));
  const unsigned voff0 = (unsigned)((wave * 8 + (lane >> 3)) * Lk * 2 + (((lane & 7) ^ ((wave * 4 + (lane >> 4)) & 7)) * 16));
  const unsigned ldst0 = (unsigned)(wave * 1024 + lane * 16);
  uint4 sg0, sg1, sg2, sg3;
  auto issue = [&](int kt, int buf) {
    char* sK = smem + buf * 32768 + ldst0;
    const unsigned ko = koff0 + (unsigned)kt * 16384u;
#pragma unroll
    for (int i = 0; i < 4; ++i) glds16((const char*)Kb + (ko + (unsigned)(i * 4096)), sK + i * 4096);
  };
#define VLOAD(kt_) do { const unsigned vo_ = voff0 + (unsigned)(kt_) * 128u; const char* vb_ = (const char*)Vb; \
    sg0 = *(const uint4*)(vb_ + vo_); sg1 = *(const uint4*)(vb_ + (vo_ + (unsigned)(64 * Lk))); \
    sg2 = *(const uint4*)(vb_ + (vo_ + (unsigned)(128 * Lk))); sg3 = *(const uint4*)(vb_ + (vo_ + (unsigned)(192 * Lk))); } while (0)
#define VSTORE(buf_) do { char* sV_ = smem + (buf_) * 32768 + 16384 + ldst0; \
    *(uint4*)(sV_) = sg0; *(uint4*)(sV_ + 4096) = sg1; *(uint4*)(sV_ + 8192) = sg2; *(uint4*)(sV_ + 12288) = sg3; } while (0)
  __syncthreads();
  issue(0, 0);
  VLOAD(0);
  VSTORE(0);
  for (int kt = 0; kt < ntile; ++kt) {
    wait_vm0();
    __syncthreads();
    if (kt + 1 < ntile) { issue(kt + 1, (kt + 1) & 1); VLOAD(kt + 1); }
    const unsigned bufo = (unsigned)(kt & 1) * 32768u;
    f32x16 Sx[2];
#pragma unroll
    for (int half = 0; half < 2; ++half) {
      const unsigned kx = bufo + (unsigned)(32 * half + r32) * 256u + (unsigned)c * 128u, kswz = (unsigned)(r32 & 15) << 4;
      bf16x8 ka[4];
#pragma unroll
      for (int ks = 0; ks < 4; ++ks) ka[ks] = *(const bf16x8*)(smem + ((kx + (unsigned)((2 * ks + hh) * 16)) ^ kswz));
#pragma unroll
      for (int i = 0; i < 16; ++i) Sx[half][i] = 0.f;
#pragma unroll
      for (int ks = 0; ks < 4; ++ks) Sx[half] = MFMA32(ka[ks], qf[ks], Sx[half]);
    }
#pragma unroll
    for (int half = 0; half < 2; ++half) {
      bf16x8 pf[2];
      bf16x8 vfr[4][2];
#pragma unroll
      for (int d = 0; d < 4; ++d) {
        const int row = 32 * d + r32;
        const unsigned vswz = (unsigned)((row >> 1) & 7) << 4;
        const unsigned vx = bufo + 16384u + (unsigned)row * 128u + 16u * (unsigned)hh + (unsigned)half * 64u;
#pragma unroll
        for (int s2 = 0; s2 < 2; ++s2) vfr[d][s2] = *(const bf16x8*)(smem + ((vx + (unsigned)(s2 * 32)) ^ vswz));
      }
      __builtin_amdgcn_sched_barrier(0);
      float mx = Sx[half][0];
#pragma unroll
      for (int i = 1; i < 16; ++i) mx = fmaxf(mx, Sx[half][i]);
      mx = fmaxf(mx, shx(mx, 32, lane));
      float mnew = fmaxf(mrun, mx);
      const bool grow = __builtin_amdgcn_ballot_w64(mnew > mrun) != 0ull;
      float ps = 0.f;
#pragma unroll
      for (int i = 0; i < 16; ++i) { float e = __builtin_amdgcn_exp2f(Sx[half][i] - mnew); Sx[half][i] = e; ps += e; }
      if (grow) {
        float alpha = __builtin_amdgcn_exp2f(mrun - mnew);
        mrun = mnew;
        lrun *= alpha;
#pragma unroll
        for (int d = 0; d < 4; ++d)
#pragma unroll
          for (int i = 0; i < 16; ++i) O[d][i] *= alpha;
      }
      lrun += ps;
#pragma unroll
      for (int s2 = 0; s2 < 2; ++s2) {
        u32x4_t w = {pack2(Sx[half][8 * s2], Sx[half][8 * s2 + 1]), pack2(Sx[half][8 * s2 + 2], Sx[half][8 * s2 + 3]),
                     pack2(Sx[half][8 * s2 + 4], Sx[half][8 * s2 + 5]), pack2(Sx[half][8 * s2 + 6], Sx[half][8 * s2 + 7])};
        pf[s2] = __builtin_bit_cast(bf16x8, w);
      }
      __builtin_amdgcn_sched_barrier(0);
#pragma unroll
      for (int d = 0; d < 4; ++d)
#pragma unroll
        for (int s2 = 0; s2 < 2; ++s2) O[d] = MFMA32(vfr[d][s2], pf[s2], O[d]);
    }
    if (kt + 1 < ntile) VSTORE((kt + 1) & 1);
  }
  const int tid2 = otid();
  const int lane2 = tid2 & 63, r32b = lane2 & 31, hhb = lane2 >> 5, qgb = tid2 >> 7, cb = (tid2 >> 6) & 1;
  const int tqb = seq_tok0(seq) + qb * 64 + qgb * 32 + r32b;
  float lsum = lrun + shx(lrun, 32, lane2);
  const int l2 = *(volatile LAS int*)(LAS int*)(smem + LDS_CTL + 4);
  const float lam = ((const float*)(p.ws + OFF_LAM))[l2];
  const float lam_init = l2 == 0 ? 0.2f : 0.35550907f;
  float inv = (cb == 0 ? 1.f : lam) / lsum;
  float* xch = (float*)smem + qgb * (32 * 132) + r32b * 132;
  __syncthreads();
  if (cb == 1) {
#pragma unroll
    for (int d = 0; d < 4; ++d)
#pragma unroll
      for (int g = 0; g < 4; ++g) {
        int dv = 32 * d + 8 * g + 4 * hhb;
        *(float4*)(xch + dv) = make_float4(O[d][4 * g] * inv, O[d][4 * g + 1] * inv, O[d][4 * g + 2] * inv, O[d][4 * g + 3] * inv);
      }
  }
  __syncthreads();
  if (cb == 0) {
    float ss = 0.f;
#pragma unroll
    for (int d = 0; d < 4; ++d)
#pragma unroll
      for (int g = 0; g < 4; ++g) {
        int dv = 32 * d + 8 * g + 4 * hhb;
        float4 o1 = *(const float4*)(xch + dv);
        float v0 = O[d][4 * g] * inv - o1.x, v1 = O[d][4 * g + 1] * inv - o1.y;
        float v2 = O[d][4 * g + 2] * inv - o1.z, v3 = O[d][4 * g + 3] * inv - o1.w;
        O[d][4 * g] = v0; O[d][4 * g + 1] = v1; O[d][4 * g + 2] = v2; O[d][4 * g + 3] = v3;
        ss += v0 * v0 + v1 * v1 + v2 * v2 + v3 * v3;
      }
    ss += shx(ss, 32, lane2);
    float rs = rsqrtf(ss * (1.f / 128.f) + EPSF) * (1.f - lam_init);
    const float* ag = p.in[18] + l2 * 128;
#pragma unroll
    for (int d = 0; d < 4; ++d)
#pragma unroll
      for (int g = 0; g < 4; ++g) {
        int dv = 32 * d + 8 * g + 4 * hhb;
        float4 gg = *(const float4*)(ag + dv);
        uint2 o;
        o.x = pack2(O[d][4 * g + 0] * rs * gg.x, O[d][4 * g + 1] * rs * gg.y);
        o.y = pack2(O[d][4 * g + 2] * rs * gg.z, O[d][4 * g + 3] * rs * gg.w);
        *(uint2*)(Q + (size_t)tqb * 512 + head * 128 + dv) = o;
      }
  }
}

__device__ void merge_phase(const Params& p, int l, int bid, int nb) {
  const int tid_ = otid();
  const int wave = tid_ >> 6, lane = tid_ & 63;
  const u16* Od = (const u16*)(p.ws + OFF_BPRE);
  const u16* Om = (const u16*)(p.ws + OFF_MOM);
  const u16* BG = (const u16*)(p.ws + OFF_BG);
  const u16* CO = (const u16*)(p.ws + OFF_CO);
  u16* cat2 = (u16*)(p.ws + OFF_U);
  const float* dg = p.in[22] + l * 64;
  const float* mg = p.in[24] + l * 64;
  for (int t = bid * 4 + wave; t < NT; t += nb * 4) {
    int c = lane * 4;
    uint2 a = *(const uint2*)(Od + (size_t)t * 256 + c), b = *(const uint2*)(Od + (size_t)(NT + t) * 256 + c);
    uint2 gt = *(const uint2*)(BG + (size_t)t * 256 + c);
    float v[4] = {bf2f(a.x & 0xffff) + bf2f(b.x & 0xffff), bf2f(a.x >> 16) + bf2f(b.x >> 16),
                  bf2f(a.y & 0xffff) + bf2f(b.y & 0xffff), bf2f(a.y >> 16) + bf2f(b.y >> 16)};
    float g[4] = {bf2f(gt.x & 0xffff), bf2f(gt.x >> 16), bf2f(gt.y & 0xffff), bf2f(gt.y >> 16)};
    float ss = v[0] * v[0] + v[1] * v[1] + v[2] * v[2] + v[3] * v[3];
#pragma unroll
    for (int o = 8; o > 0; o >>= 1) ss += shx(ss, o, lane);
    float rs = rsqrtf(ss * (1.f / 64.f) + EPSF);
    float4 w = *(const float4*)(dg + (c & 63));
    uint2 o;
    o.x = pack2(v[0] * rs * w.x * siluf(g[0]), v[1] * rs * w.y * siluf(g[1]));
    o.y = pack2(v[2] * rs * w.z * siluf(g[2]), v[3] * rs * w.w * siluf(g[3]));
    *(uint2*)(cat2 + (size_t)t * 512 + c) = o;
    a = *(const uint2*)(Om + (size_t)t * 256 + c); b = *(const uint2*)(Om + (size_t)(NT + t) * 256 + c);
    gt = *(const uint2*)(CO + (size_t)t * 256 + c);
    float v2[4] = {bf2f(a.x & 0xffff) + bf2f(b.x & 0xffff), bf2f(a.x >> 16) + bf2f(b.x >> 16),
                   bf2f(a.y & 0xffff) + bf2f(b.y & 0xffff), bf2f(a.y >> 16) + bf2f(b.y >> 16)};
    float g2[4] = {bf2f(gt.x & 0xffff), bf2f(gt.x >> 16), bf2f(gt.y & 0xffff), bf2f(gt.y >> 16)};
    ss = v2[0] * v2[0] + v2[1] * v2[1] + v2[2] * v2[2] + v2[3] * v2[3];
#pragma unroll
    for (int o2 = 8; o2 > 0; o2 >>= 1) ss += shx(ss, o2, lane);
    rs = rsqrtf(ss * (1.f / 64.f) + EPSF);
    w = *(const float4*)(mg + (c & 63));
    o.x = pack2(v2[0] * rs * w.x * sigmf(g2[0]), v2[1] * rs * w.y * sigmf(g2[1]));
    o.y = pack2(v2[2] * rs * w.z * sigmf(g2[2]), v2[3] * rs * w.w * sigmf(g2[3]));
    *(uint2*)(cat2 + (size_t)t * 512 + 256 + c) = o;
  }
}

__device__ void final_norm(const Params& p, int bid, int nb) {
  const int tid_ = otid();
  const int wave = tid_ >> 6, lane = tid_ & 63;
  const float* g = p.in[27];
  for (int t = bid * 4 + wave; t < NT; t += nb * 4) {
    float* x = p.out + (size_t)t * DM;
    float4 v[4];
    float ss = 0.f;
#pragma unroll
    for (int i = 0; i < 4; ++i) {
      v[i] = *(const float4*)(x + i * 256 + lane * 4);
      ss += v[i].x * v[i].x + v[i].y * v[i].y + v[i].z * v[i].z + v[i].w * v[i].w;
    }
    ss = wave_sum(ss, lane);
    float rs = rsqrtf(ss * (1.f / 1024.f) + EPSF);
#pragma unroll
    for (int i = 0; i < 4; ++i) {
      float4 gg = *(const float4*)(g + i * 256 + lane * 4);
      float4 o = make_float4(v[i].x * rs * gg.x, v[i].y * rs * gg.y, v[i].z * rs * gg.z, v[i].w * rs * gg.w);
      *(float4*)(x + i * 256 + lane * 4) = o;
    }
  }
}

__device__ void mixer_queue(const Params& p, int l, char* smem, int xcc) {
  int& s_item = *(int*)(smem + LDS_CTL);
  if (otid() == 0) *(volatile LAS int*)(LAS int*)(smem + LDS_CTL + 4) = l;
#pragma unroll 1
  for (int qi = 0; qi < 8; ++qi) {
    const int qx = (xcc + qi) & 7;
    unsigned* cnt = (unsigned*)(p.ws + OFF_CNT) + __builtin_amdgcn_readfirstlane(l * 8 + qx);
    for (;;) {
      __syncthreads();
      if (otid() == 0) s_item = (int)atomicAdd(cnt, 1u);
      __syncthreads();
      int u = __builtin_amdgcn_readfirstlane(s_item);
      if (u >= 200) break;
      int kind, seq, a1, a2;
      if (u < 8) { int idx = qx * 4 + (u >> 1); kind = u & 1; seq = 16 + (idx >> 3); a1 = (idx >> 1) & 3; a2 = idx & 1; }
      else if (u < 136) { int j = u - 8; int pair = 2 * qx + (j >> 6); kind = 2; seq = 16 + (pair >> 2); a1 = pair & 3; a2 = j & 63; }
      else if (u < 168) { int g = qx * 32 + (u - 136); int idx = g >> 1; kind = g & 1; seq = idx >> 3; a1 = (idx >> 1) & 3; a2 = idx & 1; }
      else { int g = qx * 32 + (u - 168); kind = 2; seq = g >> 4; a1 = (g >> 2) & 3; a2 = g & 3; }
      if (kind == 0) delta_scan(p, l, seq, a1, a2, smem);
      else if (kind == 1) mlstm_scan(p, l, seq, a1, a2, smem);
      else attn_item(p, l, seq, a1, a2, smem);
    }
  }
}

__global__ void __launch_bounds__(256, 2) mega(Params p0) {
  extern __shared__ __attribute__((aligned(16))) char smem[];
  const int bid = blockIdx.x, nb = gridDim.x;
  if (threadIdx.x == 0) { *(volatile LAS unsigned*)(LAS unsigned*)(smem + LDS_CTL + 8) = 0u; *(volatile LAS unsigned*)(LAS unsigned*)(smem + LDS_CTL + 12) = 0u; }
  __syncthreads();
  const XcdBarrier xb = xcd_barrier_post((unsigned*)(p0.ws + OFF_BAR), (volatile LAS unsigned*)(LAS unsigned*)(smem + LDS_CTL + 8));
  if (p0.rep[3] < 0) cg::this_grid().sync();

#pragma unroll 1
  for (int ph = 0; ph < 20; ++ph) {
    const Params& p = p0;
    const int l = ph < 10 ? 0 : 1;
    const int k = ph == 0 ? -1 : (ph == 19 ? 9 : (ph - 1) % 9);
    switch (k) {
      case -1:
        for (int t = bid; t < 192; t += nb) mod_task(p, t, smem);
        if (bid == nb - 1) misc_task(p);
        wconv_job(p.in[14], (u16*)(p.ws + OFF_WIN), 1024, INW, INP, 1, smem, bid, nb);
        break;
      case 0:
        norm_phase(p, l, 0, bid, nb);
        cache_conv(p, l, smem, bid, nb);
        break;
      case 1:
        gemm_phase<EPI_IN>(p, l, (const u16*)(p.ws + OFF_U), 1024, (const u16*)(p.ws + OFF_U), 1024, 1 << 30,
                           (const u16*)(p.ws + OFF_WIN), 1024, INP / 128, smem, bid, nb);
        break;
      case 2:
        for (int it = bid; it < 1280; it += nb) prep_item(p, l, it >> 2, it & 3, smem);
        break;
      case 3:
        mixer_queue(p, l, smem, (int)(xb.x & 7u));
        break;
      case 4:
        merge_phase(p, l, bid, nb);
        wconv_job(p.in[16] + (size_t)l * 1024 * 1024, (u16*)(p.ws + OFF_WOUT), 1024, 1024, 1024, 0, smem, bid, nb);
        wconv_job(p.in[25] + (size_t)l * 1024 * 2 * FF, (u16*)(p.ws + OFF_WGU), 1024, 2 * FF, 2 * FF, 2, smem, bid, nb);
        wconv_job(p.in[26] + (size_t)l * FF * 1024, (u16*)(p.ws + OFF_WDN), FF, 1024, 1024, 0, smem, bid, nb);
        if (l == 0) wconv_job(p.in[14] + (size_t)1024 * INW, (u16*)(p.ws + OFF_WIN), 1024, INW, INP, 1, smem, bid, nb);
        break;
      case 5:
        gemm_phase<EPI_RES1>(p, l, (const u16*)(p.ws + OFF_Q), 512, (const u16*)(p.ws + OFF_U), 512, 512,
                             (const u16*)(p.ws + OFF_WOUT), 1024, 8, smem, bid, nb);
        break;
      case 6:
        norm_phase(p, l, 1, bid, nb);
        break;
      case 7:
        gemm_phase_big<EPI_SWIGLU>(p, l, (const u16*)(p.ws + OFF_U), 1024, (const u16*)(p.ws + OFF_WGU), 1024, 2 * FF / 128, smem, bid, nb);
        break;
      case 8:
        gemm_phase<EPI_RES2>(p, l, (const u16*)(p.ws), FF, (const u16*)(p.ws), FF, 1 << 30,
                             (const u16*)(p.ws + OFF_WDN), FF, 8, smem, bid, nb);
        break;
      default:
        final_norm(p, bid, nb);
        break;
    }
    if (ph < 19) xcd_barrier(xb);
  }
}

extern "C" void kernel_launch(void* const* d_in, const int* in_sizes, int n_in, void* d_out, int out_size,
                              void* d_ws, size_t ws_size, hipStream_t stream) {
  static int grid_blocks = 0;
  if (!grid_blocks) {
    int dev = 0, cus = 0, per_cu = 0;
    (void)hipGetDevice(&dev);
    (void)hipDeviceGetAttribute(&cus, hipDeviceAttributeMultiprocessorCount, dev);
    (void)hipFuncSetAttribute((const void*)mega, hipFuncAttributeMaxDynamicSharedMemorySize, LDS_BYTES);
    (void)hipOccupancyMaxActiveBlocksPerMultiprocessor(&per_cu, mega, 256, LDS_BYTES);
    if (per_cu > 2) per_cu = 2;
    if (per_cu < 1) per_cu = 1;
    grid_blocks = cus * per_cu;
  }
  if (ws_size < WS_NEED) { fprintf(stderr, "workspace too small: %zu < %zu\n", ws_size, (size_t)WS_NEED); return; }
  Params p{};
  for (int i = 0; i < 28; ++i) p.in[i] = (const float*)d_in[i];
  p.out = (float*)d_out;
  p.ws = (char*)d_ws;
  p.rep[0] = REP0; p.rep[1] = REP1; p.rep[2] = REP2; p.rep[3] = REP3;
  (void)hipMemsetAsync((char*)d_ws + OFF_BAR, 0, (size_t)XCD_BAR_WORDS_C * 4, stream);
  void* args[] = {&p};
  hipError_t e = hipLaunchCooperativeKernel((void*)mega, dim3(grid_blocks), dim3(256), args, LDS_BYTES, stream);
  if (e != hipSuccess) fprintf(stderr, "cooperative launch failed: %s (grid %d)\n", hipGetErrorString(e), grid_blocks);
}
```

```cpp
#include <hip/hip_runtime.h>
#include <hip/hip_cooperative_groups.h>
#include <cstdio>
namespace cg = cooperative_groups;

typedef __attribute__((ext_vector_type(8))) short bf16x8;
typedef __attribute__((ext_vector_type(4))) short s16x4;
typedef __attribute__((ext_vector_type(4))) float f32x4;
typedef __attribute__((ext_vector_type(16))) float f32x16;
typedef unsigned short u16;

#define MFMA16(a, b, c) __builtin_amdgcn_mfma_f32_16x16x32_bf16((a), (b), (c), 0, 0, 0)
#define MFMA32(a, b, c) __builtin_amdgcn_mfma_f32_32x32x16_bf16((a), (b), (c), 0, 0, 0)

constexpr int DM = 1024;
constexpr int NT = 20480;
constexpr int NTC = 4096;
constexpr int INW = 3616;
constexpr int INP = 3712;
constexpr int FF = 2816;
constexpr float EPSF = 1e-6f;
constexpr float LOG2E = 1.4426950408889634f;
constexpr int LDS_CTL = 73728;
constexpr int LDS_BYTES = LDS_CTL + 16;
constexpr int XCD_BAR_WORDS_C = 3456;

constexpr size_t OFF_Q = 0;
constexpr size_t OFF_K = OFF_Q + (size_t)NT * 512 * 2;
constexpr size_t OFF_VT = OFF_K + (size_t)90112 * 128 * 2;
constexpr size_t OFF_BPRE = OFF_VT + (size_t)90112 * 128 * 2;
constexpr size_t OFF_BG = OFF_BPRE + (size_t)NT * 768 * 2;
constexpr size_t OFF_CQKV = OFF_BG + (size_t)NT * 256 * 2;
constexpr size_t OFF_CO = OFF_CQKV + (size_t)NT * 768 * 2;
constexpr size_t OFF_GATE = OFF_CO + (size_t)NT * 256 * 2;
constexpr size_t OFF_U = OFF_GATE + (size_t)NT * 32 * 4;
constexpr size_t OFF_P2 = OFF_U + (size_t)NT * 1024 * 2;
constexpr size_t OFF_MOM = OFF_P2 + (size_t)NT * 1024 * 2;
constexpr size_t OFF_SMALL = OFF_MOM + (size_t)NT * 512 * 2;
constexpr size_t OFF_MODV = OFF_SMALL;
constexpr size_t OFF_ROPE = OFF_MODV + 2 * 5 * 6144 * 4;
constexpr size_t OFF_LAM = OFF_ROPE + 1024 * 8;
constexpr size_t OFF_CNT = OFF_LAM + 64;
constexpr size_t OFF_DAUX = OFF_CNT + 64;
constexpr size_t OFF_MAUX = OFF_DAUX + (size_t)2560 * 128 * 4;
constexpr size_t OFF_BAR = OFF_MAUX + (size_t)2560 * 192 * 4;
constexpr size_t WS_NEED = OFF_BAR + (size_t)XCD_BAR_WORDS_C * 4;
constexpr size_t OFF_WIN = OFF_P2;
constexpr size_t OFF_WOUT = OFF_WIN + (size_t)INP * 1024 * 2;
constexpr size_t OFF_WGU = OFF_WOUT + (size_t)1024 * 1024 * 2;
constexpr size_t OFF_WDN = OFF_WGU + (size_t)2 * FF * 1024 * 2;
constexpr size_t OFF_DQKV = OFF_P2;
constexpr size_t OFF_MQK = OFF_P2 + (size_t)1280 * 3 * 4096 * 2;

constexpr size_t OUT_NK = (size_t)NT * 1024;
constexpr size_t OUT_NV = OUT_NK + 4194304;
constexpr size_t OUT_DS = OUT_NV + 4194304;
constexpr size_t OUT_MC = OUT_DS + 1048576;
constexpr size_t OUT_MN = OUT_MC + 1048576;
constexpr size_t OUT_MM = OUT_MN + 16384;

struct Params {
  const float* in[28];
  float* out;
  char* ws;
  int rep[4];
};
constexpr int REP0 = 1, REP1 = 1, REP2 = 1, REP3 = 1;

typedef __attribute__((ext_vector_type(2))) float f32x2_t;
typedef __attribute__((ext_vector_type(2))) __bf16 bf16x2_t;
__device__ __forceinline__ unsigned pack2(float a, float b) {
  f32x2_t v = {a, b};
  bf16x2_t h = __builtin_convertvector(v, bf16x2_t);
  return __builtin_bit_cast(unsigned, h);
}
__device__ __forceinline__ u16 f2bf(float f) { return (u16)(pack2(f, 0.f) & 0xffffu); }
__device__ __forceinline__ float bf2f(u16 h) { return __uint_as_float(((unsigned)h) << 16); }
__device__ __forceinline__ float siluf(float x) { return x * __builtin_amdgcn_rcpf(1.f + __expf(-x)); }
__device__ __forceinline__ float sigmf(float x) { return __builtin_amdgcn_rcpf(1.f + __expf(-x)); }
__device__ __forceinline__ float softplusf(float x) { return fmaxf(x, 0.f) + log1pf(__expf(-fabsf(x))); }
__device__ __forceinline__ float shx(float v, int o, int lane) {
  return __int_as_float(__builtin_amdgcn_ds_bpermute((lane ^ o) << 2, __float_as_int(v)));
}
__device__ __forceinline__ float shl_(float v, int src) {
  return __int_as_float(__builtin_amdgcn_ds_bpermute(src << 2, __float_as_int(v)));
}
__device__ __forceinline__ float wave_sum(float v, int lane) {
#pragma unroll
  for (int o = 32; o > 0; o >>= 1) v += shx(v, o, lane);
  return v;
}
__device__ __forceinline__ void glds16(const void* g, void* l) {
  __builtin_amdgcn_global_load_lds((const unsigned*)g, (__attribute__((address_space(3))) unsigned*)l, 16, 0, 0);
}
__device__ __forceinline__ int otid() { int t = threadIdx.x; asm volatile("" : "+v"(t)); return t; }
#define LAUNDER(q, p) const Params& q = (p);
__device__ __forceinline__ void wait_vm0() { asm volatile("s_waitcnt vmcnt(0)" ::: "memory"); }


#define XB_TMO      128
#define XB_XCNT(j)  (256  + 64 * (j))
#define XB_XSUB(j)  (1280 + 64 * (j))
#define XB_XGEN(j)  (2304 + 64 * (j))
#define XB_TOP      3328
#define XB_TOPGEN   3392
#define XCD_BAR_WORDS 3456
#define XB_SPIN_CAP (1u << 20)
#define LAS __attribute__((address_space(3)))
__device__ __forceinline__ unsigned xb_ld(unsigned* p)              { return __hip_atomic_load(p, __ATOMIC_RELAXED, __HIP_MEMORY_SCOPE_AGENT); }
__device__ __forceinline__ unsigned xb_add(unsigned* p, unsigned v) { return __hip_atomic_fetch_add(p, v, __ATOMIC_RELAXED, __HIP_MEMORY_SCOPE_AGENT); }
__device__ __forceinline__ unsigned xb_xcc_id() { return (unsigned)__builtin_amdgcn_s_getreg((3 << 11) | 20) & 0xFu; }
#define XB_SPIN(cond, bar) do { unsigned _sp = 0; while (cond) { __builtin_amdgcn_s_sleep(1); \
    if ((++_sp & 255u) == 0u) { if (xb_ld(&(bar)[XB_TMO])) break; if (_sp > XB_SPIN_CAP) { atomicAdd(&(bar)[XB_TMO], 1u); break; } } } } while (0)
struct XcdBarrier { unsigned* bar; unsigned x; volatile LAS unsigned* st; };
__device__ __forceinline__ XcdBarrier xcd_barrier_post(unsigned* bar, volatile LAS unsigned* st) {
  XcdBarrier b; b.bar = bar; b.x = xb_xcc_id(); b.st = st;
  if (threadIdx.x == 0) (void)xb_add(&bar[XB_XCNT(b.x)], 1u);
  return b;
}
__device__ __forceinline__ void xcd_barrier_complete(unsigned* bar, unsigned x, unsigned& nloc, unsigned& nx) {
  const unsigned G = gridDim.x * gridDim.y * gridDim.z;
  unsigned sum, cnt, mine, sp = 0u;
  for (;;) {
    sum = 0u; cnt = 0u; mine = 0u;
#pragma unroll
    for (unsigned j = 0; j < 16; ++j) { const unsigned c = xb_ld(&bar[XB_XCNT(j)]); sum += c; cnt += (c > 0u) ? 1u : 0u; mine = (j == x) ? c : mine; }
    if (sum == G) break;
    __builtin_amdgcn_s_sleep(1);
    if ((++sp & 255u) == 0u) { if (xb_ld(&bar[XB_TMO])) break; if (sp > XB_SPIN_CAP) { atomicAdd(&bar[XB_TMO], 1u); break; } }
  }
  nloc = mine > 0u ? mine : 1u; nx = cnt > 0u ? cnt : 1u;
}
__device__ __forceinline__ void xcd_barrier(const XcdBarrier& b) {
  asm volatile("s_waitcnt vmcnt(0)" ::: "memory");
  __syncthreads();
  if (threadIdx.x == 0) {
    unsigned* bar = b.bar;
    __builtin_amdgcn_s_waitcnt(0);
    unsigned nloc = b.st[0], nx = b.st[1];
    if (nloc == 0u) { xcd_barrier_complete(bar, b.x, nloc, nx); b.st[0] = nloc; b.st[1] = nx; }
    const unsigned old = xb_add(&bar[XB_XSUB(b.x)], 1u);
    const unsigned gen = old / nloc;
    if (old + 1u == (gen + 1u) * nloc) {
      __builtin_amdgcn_fence(__ATOMIC_RELEASE, "agent");
      asm volatile("s_waitcnt vmcnt(0)" ::: "memory");
      const unsigned og = xb_add(&bar[XB_TOP], 1u);
      const unsigned tg = og / nx;
      if (og + 1u == (tg + 1u) * nx) xb_add(&bar[XB_TOPGEN], 1u);
      else XB_SPIN(xb_ld(&bar[XB_TOPGEN]) == tg, bar);
      __builtin_amdgcn_fence(__ATOMIC_ACQUIRE, "agent");
      xb_add(&bar[XB_XGEN(b.x)], 1u);
      asm volatile("s_waitcnt vmcnt(0)" ::: "memory");
    } else {
      XB_SPIN(xb_ld(&bar[XB_XGEN(b.x)]) == gen, bar);
      __builtin_amdgcn_fence(__ATOMIC_ACQUIRE, "agent");
      asm volatile("s_waitcnt vmcnt(0)" ::: "memory");
    }
  }
  __syncthreads();
}

__device__ __forceinline__ int tok_seq(int t) { return t < NTC ? (t >> 8) : 16 + ((t - NTC) >> 12); }
__device__ __forceinline__ int seq_tok0(int s) { return s < 16 ? s * 256 : NTC + (s - 16) * 4096; }
__device__ __forceinline__ int seq_len(int s) { return s < 16 ? 256 : 4096; }
__device__ __forceinline__ int seq_lk(int s) { return s < 16 ? 256 : 4608; }
__device__ __forceinline__ int seq_mv(int s) { return s < 16 ? 0 : s - 15; }
__device__ __forceinline__ size_t krow0(int s, int h) {
  return s < 16 ? (size_t)(s * 4 + h) * 256 : (size_t)16384 + (size_t)((s - 16) * 4 + h) * 4608;
}
__device__ __forceinline__ const float* xrow_ptr(const Params& p, int l, int t) {
  if (l == 0) return t < NTC ? p.in[0] + (size_t)t * DM : p.in[1] + (size_t)(t - NTC) * DM;
  return p.out + (size_t)t * DM;
}
__device__ __forceinline__ int in_src_col(int n) {
  if (n < 2560) return n;
  if (n < 3584) return n + 16;
  if (n < 3600) return n - 3584 + 2560;
  if (n < 3616) return n;
  return -1;
}

__device__ void wconv_tile(const float* W, int K, int N, u16* Wt, int mode, int kt, int nt, char* smem) {
  float* tile = (float*)smem;
  const int tid = otid();
  __syncthreads();
  for (int e = tid; e < 1024; e += 256) {
    int kk = e >> 4, nn = (e & 15) * 4;
    int nd = nt * 64 + nn;
    int src;
    if (mode == 0) src = nd;
    else if (mode == 1) src = in_src_col(nd);
    else {
      int t128 = nd >> 7, w = nd & 127; int pq = w >> 5, half = (w >> 4) & 1, r = w & 15;
      src = half * FF + t128 * 64 + (pq >> 1) * 32 + (r >> 2) * 8 + (pq & 1) * 4 + (r & 3);
    }
    float4 v = make_float4(0.f, 0.f, 0.f, 0.f);
    if (src >= 0) v = *(const float4*)(W + (size_t)(kt * 64 + kk) * N + src);
    float* d = tile + kk * 65 + nn;
    d[0] = v.x; d[1] = v.y; d[2] = v.z; d[3] = v.w;
  }
  __syncthreads();
  for (int e = tid; e < 2048; e += 256) {
    int nn = e >> 5, k2 = (e & 31) * 2;
    unsigned v = pack2(tile[k2 * 65 + nn], tile[(k2 + 1) * 65 + nn]);
    *(unsigned*)(Wt + (size_t)(nt * 64 + nn) * K + kt * 64 + k2) = v;
  }
}

__device__ void wconv_job(const float* W, u16* Wt, int K, int N, int Np, int mode, char* smem, int bid, int nb) {
  int nkt = K / 64, nnt = Np / 64;
  for (int t = bid; t < nkt * nnt; t += nb) wconv_tile(W, K, N, Wt, mode, t / nnt, t % nnt, smem);
}

__device__ void mod_task(const Params& p, int task, char* smem) {
  float* sc = (float*)smem;
  float* red = sc + 5 * 1024;
  const int tid = otid();
  __syncthreads();
  for (int e = tid; e < 5 * 1024; e += 256) {
    int mv = e >> 10, k = e & 1023;
    float c = mv == 0 ? p.in[9][k] : p.in[8][(mv - 1) * 1024 + k];
    sc[e] = siluf(c);
  }
  __syncthreads();
  int l = task / 96, cg0 = (task % 96) * 64;
  int quad = tid & 15, kg = tid >> 4;
  const float* W = p.in[12] + (size_t)l * 1024 * 6144 + cg0 + quad * 4;
  float acc[5][4];
#pragma unroll
  for (int a = 0; a < 5; ++a)
#pragma unroll
    for (int b = 0; b < 4; ++b) acc[a][b] = 0.f;
  for (int kk = 0; kk < 64; ++kk) {
    int k = kg * 64 + kk;
    float4 w = *(const float4*)(W + (size_t)k * 6144);
#pragma unroll
    for (int a = 0; a < 5; ++a) {
      float s = sc[a * 1024 + k];
      acc[a][0] += s * w.x; acc[a][1] += s * w.y; acc[a][2] += s * w.z; acc[a][3] += s * w.w;
    }
  }
#pragma unroll
  for (int a = 0; a < 5; ++a)
#pragma unroll
    for (int b = 0; b < 4; ++b) red[(kg * 5 + a) * 64 + quad * 4 + b] = acc[a][b];
  __syncthreads();
  float* modv = (float*)(p.ws + OFF_MODV);
  for (int e = tid; e < 320; e += 256) {
    int a = e >> 6, c = e & 63;
    float s = p.in[13][l * 6144 + cg0 + c];
    for (int g = 0; g < 16; ++g) s += red[(g * 5 + a) * 64 + c];
    modv[(size_t)(l * 5 + a) * 6144 + cg0 + c] = s;
  }
}

__device__ void misc_task(const Params& p) {
  const int tid = otid();
  float2* rope = (float2*)(p.ws + OFF_ROPE);
  for (int e = tid; e < 1024; e += 256) {
    int pos = e >> 4, f = e & 15;
    float inv = powf(10000.f, -(float)f / 16.f);
    float ang = (float)pos * inv;
    rope[e] = make_float2(cosf(ang), sinf(ang));
  }
  if (tid < 2) {
    const float* lq = p.in[17] + tid * 256;
    float s1 = 0.f, s2 = 0.f;
    for (int i = 0; i < 64; ++i) { s1 += lq[i] * lq[64 + i]; s2 += lq[128 + i] * lq[192 + i]; }
    float lam_init = 0.8f - 0.6f * expf(-0.3f * (float)tid);
    ((float*)(p.ws + OFF_LAM))[tid] = expf(s1) - expf(s2) + lam_init;
  }
  if (tid < 16) ((unsigned*)(p.ws + OFF_CNT))[tid] = 0u;
}

__device__ void norm_phase(const Params& p, int l, int which, int bid, int nb) {
  const int tid_ = otid();
  const int wave = tid_ >> 6, lane = tid_ & 63;
  const float* g = p.in[which == 0 ? 10 : 11] + l * 1024;
  const float* modv = (const float*)(p.ws + OFF_MODV);
  u16* U = (u16*)(p.ws + OFF_U);
  for (int t = bid * 4 + wave; t < NT; t += nb * 4) {
    const float* x = xrow_ptr(p, which == 0 ? l : 1, t);
    int mv = seq_mv(tok_seq(t));
    const float* sh = modv + (size_t)(l * 5 + mv) * 6144 + (which == 0 ? 0 : 3) * 1024;
    const float* sc = sh + 1024;
    float4 v[4];
    float ss = 0.f;
#pragma unroll
    for (int i = 0; i < 4; ++i) {
      v[i] = *(const float4*)(x + i * 256 + lane * 4);
      ss += v[i].x * v[i].x + v[i].y * v[i].y + v[i].z * v[i].z + v[i].w * v[i].w;
    }
    ss = wave_sum(ss, lane);
    float rs = rsqrtf(ss * (1.f / 1024.f) + EPSF);
#pragma unroll
    for (int i = 0; i < 4; ++i) {
      int c = i * 256 + lane * 4;
      float4 gg = *(const float4*)(g + c), s4 = *(const float4*)(sc + c), h4 = *(const float4*)(sh + c);
      float a0 = v[i].x * rs * gg.x * (1.f + s4.x) + h4.x;
      float a1 = v[i].y * rs * gg.y * (1.f + s4.y) + h4.y;
      float a2 = v[i].z * rs * gg.z * (1.f + s4.z) + h4.z;
      float a3 = v[i].w * rs * gg.w * (1.f + s4.w) + h4.w;
      uint2 o; o.x = pack2(a0, a1); o.y = pack2(a2, a3);
      *(uint2*)(U + (size_t)t * 1024 + c) = o;
    }
  }
}

__device__ void cache_conv(const Params& p, int l, char* smem, int bid, int nb) {
  u16* K = (u16*)(p.ws + OFF_K);
  u16* VT = (u16*)(p.ws + OFF_VT);
  const int tid_ = otid();
  for (int e = bid * 256 + tid_; e < 262144; e += nb * 256) {
    int c4 = (e & 31) * 4, h = (e >> 5) & 3, pt = (e >> 7) & 511, b = e >> 16;
    float4 v = *(const float4*)(p.in[2] + ((size_t)((b * 2 + l) * 512 + pt) * 4 + h) * 128 + c4);
    uint2 o; o.x = pack2(v.x, v.y); o.y = pack2(v.z, v.w);
    *(uint2*)(K + (krow0(16 + b, h) + 4096 + pt) * 128 + c4) = o;
  }
  u16* T = (u16*)smem;
  for (int tile = bid; tile < 128; tile += nb) {
    int pt0 = (tile & 7) * 64, h = (tile >> 3) & 3, b = tile >> 5;
    __syncthreads();
    for (int e = tid_; e < 2048; e += 256) {
      int pt = e >> 5, c4 = (e & 31) * 4;
      float4 v = *(const float4*)(p.in[3] + ((size_t)((b * 2 + l) * 512 + pt0 + pt) * 4 + h) * 128 + c4);
      const int a4 = (pt >> 2) & 3;
      const int pp = (pt & ~15) | ((((a4 & 1) << 1) | (a4 >> 1)) << 2) | (pt & 3);
      T[(c4 + 0) * 72 + pp] = f2bf(v.x); T[(c4 + 1) * 72 + pp] = f2bf(v.y);
      T[(c4 + 2) * 72 + pp] = f2bf(v.z); T[(c4 + 3) * 72 + pp] = f2bf(v.w);
    }
    __syncthreads();
    for (int e = tid_; e < 1024; e += 256) {
      int c = e >> 3, ch = e & 7;
      uint4 v = *(const uint4*)(T + c * 72 + ch * 8);
      *(uint4*)(VT + krow0(16 + b, h) * 128 + (size_t)c * 4608 + 4096 + pt0 + ch * 8) = v;
    }
  }
}

enum { EPI_IN = 0, EPI_RES1 = 1, EPI_SWIGLU = 2, EPI_RES2 = 3 };

template <int EPI>
__device__ __forceinline__ void gemm_epilogue(const Params& p, int l, int rowbase, int nt, f32x4 (&acc)[4][4]) {
  const int tid_ = otid();
  const int lane = tid_ & 63, wave = tid_ >> 6;
  const int wn = wave & 1, r = lane & 15, q = lane >> 4;
  const int m0 = rowbase;
  const int seq = tok_seq(m0);
  const int mv = seq_mv(seq);
  const float* modv = (const float*)(p.ws + OFF_MODV) + (size_t)(l * 5 + mv) * 6144;
  if (EPI == EPI_RES1 || EPI == EPI_RES2) {
    const float* gate = modv + (EPI == EPI_RES1 ? 2 : 5) * 1024;
    float4 x4[4][4], g4[4];
#pragma unroll
    for (int ns = 0; ns < 4; ++ns) g4[ns] = *(const float4*)(gate + nt * 128 + wn * 64 + ns * 16 + 4 * q);
#pragma unroll
    for (int ms = 0; ms < 4; ++ms) {
      const int t = m0 + ms * 16 + r;
      const float* xr = (EPI == EPI_RES1) ? xrow_ptr(p, l, t) : p.out + (size_t)t * DM;
#pragma unroll
      for (int ns = 0; ns < 4; ++ns) x4[ms][ns] = *(const float4*)(xr + nt * 128 + wn * 64 + ns * 16 + 4 * q);
    }
#pragma unroll
    for (int ms = 0; ms < 4; ++ms) {
      const int t = m0 + ms * 16 + r;
      float* xo = p.out + (size_t)t * DM;
#pragma unroll
      for (int ns = 0; ns < 4; ++ns) {
        const int col = nt * 128 + wn * 64 + ns * 16 + 4 * q;
        float4 o;
        o.x = x4[ms][ns].x + g4[ns].x * acc[ms][ns][0]; o.y = x4[ms][ns].y + g4[ns].y * acc[ms][ns][1];
        o.z = x4[ms][ns].z + g4[ns].z * acc[ms][ns][2]; o.w = x4[ms][ns].w + g4[ns].w * acc[ms][ns][3];
        *(float4*)(xo + col) = o;
      }
    }
  } else if (EPI == EPI_SWIGLU) {
    u16* H = (u16*)(p.ws);
#pragma unroll
    for (int ms = 0; ms < 4; ++ms) {
      const int t = m0 + ms * 16 + r;
      float hv[2][4];
#pragma unroll
      for (int pp = 0; pp < 2; ++pp)
#pragma unroll
        for (int i = 0; i < 4; ++i) hv[pp][i] = siluf(acc[ms][2 * pp][i]) * acc[ms][2 * pp + 1][i];
      uint4 o;
      o.x = pack2(hv[0][0], hv[0][1]); o.y = pack2(hv[0][2], hv[0][3]);
      o.z = pack2(hv[1][0], hv[1][1]); o.w = pack2(hv[1][2], hv[1][3]);
      *(uint4*)(H + (size_t)t * FF + nt * 64 + wn * 32 + q * 8) = o;
    }
  } else {
    const bool latent = seq >= 16;
    const int tok0 = seq_tok0(seq);
    const float* bias = p.in[15] + l * INW;
    const float2* rope = (const float2*)(p.ws + OFF_ROPE);
#pragma unroll
    for (int ms = 0; ms < 4; ++ms)
#pragma unroll
      for (int ns = 0; ns < 4; ++ns) {
        int c = wn * 64 + ns * 16 + r;
        int ncol = nt * 128 + c;
        int sc = in_src_col(ncol);
        float bv = sc >= 0 ? bias[sc] : 0.f;
        float v[4];
#pragma unroll
        for (int i = 0; i < 4; ++i) v[i] = acc[ms][ns][i] + bv;
        int tb = m0 + ms * 16 + 4 * q;
        if (nt < 8) {
          int head = nt & 3;
          if (latent) {
            int d = c & 63, pi = d >> 1;
#pragma unroll
            for (int i = 0; i < 4; ++i) {
              float other = shx(v[i], 1, lane);
              int tl = tb + i - tok0;
              int pos = pi < 16 ? (tl >> 6) : (tl & 63);
              float2 cs = rope[pos * 16 + (pi & 15)];
              v[i] = (d & 1) ? (other * cs.y + v[i] * cs.x) : (v[i] * cs.x - other * cs.y);
            }
          }
          if (nt < 4) {
            u16* Q = (u16*)(p.ws + OFF_Q);
#pragma unroll
            for (int i = 0; i < 4; ++i) Q[(size_t)(tb + i) * 512 + head * 128 + c] = f2bf(v[i] * (0.125f * LOG2E));
          } else {
            u16* K = (u16*)(p.ws + OFF_K);
            size_t kr = krow0(seq, head) + (tb - tok0);
#pragma unroll
            for (int i = 0; i < 4; ++i) K[(kr + i) * 128 + c] = f2bf(v[i]);
            if (!latent) {
#pragma unroll
              for (int i = 0; i < 4; ++i)
                p.out[OUT_NK + ((size_t)((seq * 2 + l) * 256 + (tb + i - tok0)) * 4 + head) * 128 + c] = v[i];
            }
          }
        } else if (nt < 12) {
          int head = nt - 8;
          u16* VT = (u16*)(p.ws + OFF_VT);
          uint2 o; o.x = pack2(v[0], v[1]); o.y = pack2(v[2], v[3]);
          const int tl0 = tb - tok0;
          const int a4 = (tl0 >> 2) & 3;
          const int tperm = (tl0 & ~15) | ((((a4 & 1) << 1) | (a4 >> 1)) << 2);
          *(uint2*)(VT + krow0(seq, head) * 128 + (size_t)c * seq_lk(seq) + tperm) = o;
          if (!latent) {
#pragma unroll
            for (int i = 0; i < 4; ++i)
              p.out[OUT_NV + ((size_t)((seq * 2 + l) * 256 + (tb + i - tok0)) * 4 + head) * 128 + c] = v[i];
          }
        } else if (nt < 18) {
          u16* B = (u16*)(p.ws + OFF_BPRE);
#pragma unroll
          for (int i = 0; i < 4; ++i) B[(size_t)(tb + i) * 768 + (nt - 12) * 128 + c] = f2bf(v[i]);
        } else if (nt < 20) {
          u16* B = (u16*)(p.ws + OFF_BG);
#pragma unroll
          for (int i = 0; i < 4; ++i) B[(size_t)(tb + i) * 256 + (nt - 18) * 128 + c] = f2bf(v[i]);
        } else if (nt < 26) {
          u16* B = (u16*)(p.ws + OFF_CQKV);
          float s = (nt == 22 || nt == 23) ? 0.125f : 1.f;
#pragma unroll
          for (int i = 0; i < 4; ++i) B[(size_t)(tb + i) * 768 + (nt - 20) * 128 + c] = f2bf(v[i] * s);
        } else if (nt < 28) {
          u16* B = (u16*)(p.ws + OFF_CO);
#pragma unroll
          for (int i = 0; i < 4; ++i) B[(size_t)(tb + i) * 256 + (nt - 26) * 128 + c] = f2bf(v[i]);
        } else {
          if (c < 32) {
            float* G = (float*)(p.ws + OFF_GATE);
#pragma unroll
            for (int i = 0; i < 4; ++i) G[(size_t)(tb + i) * 32 + c] = v[i];
          }
        }
      }
  }
}

template <int EPI>
__device__ void gemm_tile(const Params& p, int l, const u16* A0, int lda0, const u16* A1, int lda1, int ksplit,
                          const u16* Bt, int K, int mt, int nt, char* smem) {
  const int tid = otid(), lane = tid & 63, wave = tid >> 6;
  const int wm = wave >> 1, wn = wave & 1, r = lane & 15, q = lane >> 4;
  const int nk = K / 64;
  f32x4 acc[4][4];
#pragma unroll
  for (int a = 0; a < 4; ++a)
#pragma unroll
    for (int b = 0; b < 4; ++b) acc[a][b] = (f32x4){0.f, 0.f, 0.f, 0.f};

  const int srow = wave * 8 + (lane >> 3);
  const unsigned kcb = (unsigned)(((lane & 7) ^ ((srow >> 1) & 7)) * 16);
  const unsigned ldst0 = (unsigned)(wave * 1024 + lane * 16);
  auto issue = [&](int kt, int buf) {
    char* sA = smem + buf * 32768 + ldst0;
    char* sB = sA + 16384;
    const int k0 = kt * 64;
    const char* Ab; unsigned lda2; unsigned ka;
    if (k0 < ksplit) { Ab = (const char*)(A0 + (size_t)mt * 128 * lda0); lda2 = (unsigned)lda0 * 2; ka = (unsigned)k0 * 2; }
    else { Ab = (const char*)(A1 + (size_t)mt * 128 * lda1); lda2 = (unsigned)lda1 * 2; ka = (unsigned)(k0 - ksplit) * 2; }
    const char* Bb = (const char*)(Bt + (size_t)nt * 128 * K);
    const unsigned ao = (unsigned)srow * lda2 + kcb + ka, bo = (unsigned)srow * (unsigned)(K * 2) + kcb + (unsigned)k0 * 2;
#pragma unroll
    for (int i = 0; i < 4; ++i) {
      glds16(Ab + (ao + (unsigned)i * 32u * lda2), sA + i * 4096);
      glds16(Bb + (bo + (unsigned)i * 32u * (unsigned)(K * 2)), sB + i * 4096);
    }
  };
  __syncthreads();
  issue(0, 0);
  for (int kt = 0; kt < nk; ++kt) {
    wait_vm0();
    __syncthreads();
    if (kt + 1 < nk) issue(kt + 1, (kt + 1) & 1);
    const char* sA = smem + (kt & 1) * 32768;
    const char* sB = sA + 16384;
    __builtin_amdgcn_iglp_opt(0);
#pragma unroll
    for (int s = 0; s < 2; ++s) {
      bf16x8 af[4], bfr[4];
#pragma unroll
      for (int ms = 0; ms < 4; ++ms) {
        int row = wm * 64 + ms * 16 + r;
        af[ms] = *(const bf16x8*)(sA + row * 128 + (((s * 4 + q) ^ ((row >> 1) & 7)) * 16));
      }
#pragma unroll
      for (int ns = 0; ns < 4; ++ns) {
        int row = wn * 64 + ns * 16 + r;
        bfr[ns] = *(const bf16x8*)(sB + row * 128 + (((s * 4 + q) ^ ((row >> 1) & 7)) * 16));
      }
#pragma unroll
      for (int ms = 0; ms < 4; ++ms)
#pragma unroll
        for (int ns = 0; ns < 4; ++ns)
          acc[ms][ns] = (EPI == EPI_IN) ? MFMA16(af[ms], bfr[ns], acc[ms][ns]) : MFMA16(bfr[ns], af[ms], acc[ms][ns]);
    }
  }
  gemm_epilogue<EPI>(p, l, mt * 128 + wm * 64, nt, acc);
}


__device__ __forceinline__ bool tile_map(int bid, int nb, int it, int ntm, int ntn, int& m, int& n) {
  if (nb != 512 || (ntm & 7)) {
    int t = bid + it * nb;
    if (t >= ntm * ntn) return false;
    m = t % ntm; n = t / ntm;
    return true;
  }
  const int x = bid & 7, j = bid >> 3, MX = ntm >> 3;
  int u = it * 64 + j;
  const int fullp = ntn >> 3;
  int np, wp;
  if (u < fullp * 8 * MX) { np = u / (8 * MX); u -= np * 8 * MX; wp = 8; }
  else { np = fullp; u -= fullp * 8 * MX; wp = ntn & 7; if (u >= wp * MX) return false; }
  m = x * MX + u / wp;
  n = np * 8 + u % wp;
  return true;
}

template <int EPI>
__device__ void gemm_phase(const Params& p, int l, const u16* A0, int lda0, const u16* A1, int lda1, int ksplit,
                           const u16* Bt, int K, int ntn, char* smem, int bid, int nb) {
  const int ntm = NT / 128;
  int m, n;
  for (int it = 0; tile_map(bid, nb, it, ntm, ntn, m, n); ++it) gemm_tile<EPI>(p, l, A0, lda0, A1, lda1, ksplit, Bt, K, m, n, smem);
}


template <int EPI>
__device__ void gemm_tile_big(const Params& p, int l, const u16* A, int lda, const u16* Bt, int K, int mt, int nt, char* smem) {
  const int tid = otid(), lane = tid & 63, wave = tid >> 6;
  const int wm = wave >> 1, wn = wave & 1, r = lane & 15, q = lane >> 4;
  const int nk = K / 32;
  f32x4 acc[2][4][4];
#pragma unroll
  for (int hf = 0; hf < 2; ++hf)
#pragma unroll
    for (int a = 0; a < 4; ++a)
#pragma unroll
      for (int b = 0; b < 4; ++b) acc[hf][a][b] = (f32x4){0.f, 0.f, 0.f, 0.f};
  const int srow = wave * 16 + (lane >> 2);
  const unsigned kcb = (unsigned)(((lane & 3) ^ ((srow >> 2) & 3)) * 16);
  const unsigned ldst0 = (unsigned)(wave * 1024 + lane * 16);
  const char* Ab = (const char*)(A + (size_t)mt * 256 * lda);
  const char* Bb = (const char*)(Bt + (size_t)nt * 128 * K);
  const unsigned lda2 = (unsigned)lda * 2, ldb2 = (unsigned)K * 2;
  auto issue = [&](int kt, int buf) {
    char* sA = smem + buf * 24576 + ldst0;
    char* sB = sA + 16384;
    const unsigned ao = (unsigned)srow * lda2 + kcb + (unsigned)kt * 64u, bo = (unsigned)srow * ldb2 + kcb + (unsigned)kt * 64u;
#pragma unroll
    for (int i = 0; i < 4; ++i) glds16(Ab + (ao + (unsigned)i * 64u * lda2), sA + i * 4096);
#pragma unroll
    for (int i = 0; i < 2; ++i) glds16(Bb + (bo + (unsigned)i * 64u * ldb2), sB + i * 4096);
  };
  __syncthreads();
  issue(0, 0);
  issue(1, 1);
  int stg = 0;
  for (int kt = 0; kt < nk; ++kt) {
    if (kt + 1 < nk) asm volatile("s_waitcnt vmcnt(6)" ::: "memory");
    else asm volatile("s_waitcnt vmcnt(0)" ::: "memory");
    __builtin_amdgcn_s_barrier();
    if (kt + 2 < nk) issue(kt + 2, stg >= 1 ? stg - 1 : 2);
    const unsigned bo = (unsigned)stg * 24576u;
    stg = stg == 2 ? 0 : stg + 1;
    __builtin_amdgcn_iglp_opt(0);
    bf16x8 bfr[4];
#pragma unroll
    for (int ns = 0; ns < 4; ++ns) {
      int row = wn * 64 + ns * 16 + r;
      bfr[ns] = *(const bf16x8*)(smem + bo + 16384u + (unsigned)row * 64u + (unsigned)((q ^ ((row >> 2) & 3)) * 16));
    }
#pragma unroll
    for (int hf = 0; hf < 2; ++hf) {
      bf16x8 af[4];
#pragma unroll
      for (int ms = 0; ms < 4; ++ms) {
        int row = wm * 128 + hf * 64 + ms * 16 + r;
        af[ms] = *(const bf16x8*)(smem + bo + (unsigned)row * 64u + (unsigned)((q ^ ((row >> 2) & 3)) * 16));
      }
#pragma unroll
      for (int ms = 0; ms < 4; ++ms)
#pragma unroll
        for (int ns = 0; ns < 4; ++ns) acc[hf][ms][ns] = MFMA16(bfr[ns], af[ms], acc[hf][ms][ns]);
    }
  }
  gemm_epilogue<EPI>(p, l, mt * 256 + wm * 128, nt, acc[0]);
  gemm_epilogue<EPI>(p, l, mt * 256 + wm * 128 + 64, nt, acc[1]);
}

template <int EPI>
__device__ void gemm_phase_big(const Params& p, int l, const u16* A, int lda, const u16* Bt, int K, int ntn, char* smem, int bid, int nb) {
  const int ntm = NT / 256;
  int m, n;
  for (int it = 0; tile_map(bid, nb, it, ntm, ntn, m, n); ++it) gemm_tile_big<EPI>(p, l, A, lda, Bt, K, m, n, smem);
}

__device__ void prep_item(const Params& p, int l, int ci, int h, char* smem) {
  const int tid = otid(), lane = tid & 63, wave = tid >> 6;
  float* qs = (float*)smem;
  float* ks = qs + 64 * 65;
  float* As = (float*)smem;
  float* gcs = (float*)(smem + 33280);
  float* bes = gcs + 128;
  const int t0 = ci * 64;
  const int seq = tok_seq(t0);
  const int stok0 = seq_tok0(seq), slen = seq_len(seq);
  const int ti = tid >> 4, tj = tid & 15;
  const int item = ci * 4 + h;
  __syncthreads();
  {
    const u16* C = (const u16*)(p.ws + OFF_CQKV);
    for (int e = tid; e < 1024; e += 256) {
      int t = (e >> 3) & 63, ch = e & 7, isk = e >> 9;
      uint4 v = *(const uint4*)(C + (size_t)(t0 + t) * 768 + isk * 256 + h * 64 + ch * 8);
      float* dst = (isk ? ks : qs) + t * 65 + ch * 8;
      dst[0] = bf2f(v.x & 0xffff); dst[1] = bf2f(v.x >> 16); dst[2] = bf2f(v.y & 0xffff); dst[3] = bf2f(v.y >> 16);
      dst[4] = bf2f(v.z & 0xffff); dst[5] = bf2f(v.z >> 16); dst[6] = bf2f(v.w & 0xffff); dst[7] = bf2f(v.w >> 16);
    }
    if (wave < 2) {
      const int dir = wave, i = lane;
      const int t = t0 + (dir ? 63 - i : i);
      const float* G = (const float*)(p.ws + OFF_GATE) + (size_t)t * 32 + dir * 4 + h;
      float ba = G[0], bb = G[8], ig = G[16], cf = G[24] + p.in[23][l * 8 + dir * 4 + h];
      float lf = fminf(cf, 0.f) - log1pf(__expf(-fabsf(cf)));
      float g = -__expf(p.in[20][l * 8 + dir * 4 + h]) * softplusf(ba + p.in[21][l * 8 + dir * 4 + h]);
      float be = sigmf(bb);
      float b = lf, gc = g;
#pragma unroll
      for (int o = 1; o < 64; o <<= 1) {
        float tb = shl_(b, (lane - o) & 63), tg = shl_(gc, (lane - o) & 63);
        if (lane >= o) { b += tb; gc += tg; }
      }
      float a = ig - b, pm = a;
#pragma unroll
      for (int o = 1; o < 64; o <<= 1) {
        float tp = shl_(pm, (lane - o) & 63);
        if (lane >= o) pm = fmaxf(pm, tp);
      }
      float* maux = (float*)(p.ws + OFF_MAUX) + (size_t)(item * 2 + dir) * 192;
      maux[i] = b; maux[64 + i] = a; maux[128 + i] = pm;
      float* daux = (float*)(p.ws + OFF_DAUX) + (size_t)(item * 2 + dir) * 128;
      daux[i] = gc; daux[64 + i] = be;
      gcs[dir * 64 + i] = gc; bes[dir * 64 + i] = be;
    }
    __syncthreads();
    float acc[4][4];
#pragma unroll
    for (int a = 0; a < 4; ++a)
#pragma unroll
      for (int b = 0; b < 4; ++b) acc[a][b] = 0.f;
    for (int d = 0; d < 64; ++d) {
      float x[4], y[4];
#pragma unroll
      for (int a = 0; a < 4; ++a) { x[a] = qs[(4 * ti + a) * 65 + d]; y[a] = ks[(4 * tj + a) * 65 + d]; }
#pragma unroll
      for (int a = 0; a < 4; ++a)
#pragma unroll
        for (int b = 0; b < 4; ++b) acc[a][b] += x[a] * y[b];
    }
    u16* MQK = (u16*)(p.ws + OFF_MQK) + (size_t)item * 4096;
#pragma unroll
    for (int a = 0; a < 4; ++a) {
      uint2 o; o.x = pack2(acc[a][0], acc[a][1]); o.y = pack2(acc[a][2], acc[a][3]);
      *(uint2*)(MQK + (4 * ti + a) * 64 + 4 * tj) = o;
    }
    __syncthreads();
  }
  {
    const u16* B = (const u16*)(p.ws + OFF_BPRE);
    const float* cw = p.in[19] + l * 5 * 768;
    u16* DQ = (u16*)(p.ws + OFF_DQKV) + (size_t)item * 3 * 4096;
    float* xs = (float*)(smem + 34304);
#pragma unroll 1
    for (int part = 0; part < 3; ++part) {
      int ch = part * 256 + h * 64 + lane;
      float w0 = cw[ch], w1 = cw[768 + ch], w2 = cw[2 * 768 + ch], w3 = cw[3 * 768 + ch], w4 = cw[4 * 768 + ch];
      __syncthreads();
      for (int e = tid; e < 544; e += 256) {
        int rr = e >> 3, c8 = e & 7;
        int tl = (t0 - stok0) + rr - 2;
        uint4 v = make_uint4(0u, 0u, 0u, 0u);
        if (tl >= 0 && tl < slen) v = *(const uint4*)(B + (size_t)(stok0 + tl) * 768 + part * 256 + h * 64 + c8 * 8);
        float* dst = xs + rr * 64 + c8 * 8;
        dst[0] = bf2f(v.x & 0xffff); dst[1] = bf2f(v.x >> 16); dst[2] = bf2f(v.y & 0xffff); dst[3] = bf2f(v.y >> 16);
        dst[4] = bf2f(v.z & 0xffff); dst[5] = bf2f(v.z >> 16); dst[6] = bf2f(v.w & 0xffff); dst[7] = bf2f(v.w >> 16);
      }
      __syncthreads();
#pragma unroll 4
      for (int i = 0; i < 16; ++i) {
        int t = wave + 4 * i;
        const float* xr = xs + t * 64 + lane;
        float v = siluf(w0 * xr[0] + w1 * xr[64] + w2 * xr[128] + w3 * xr[192] + w4 * xr[256]);
        if (part < 2) {
          float ss = wave_sum(v * v, lane);
          v *= rsqrtf(ss + EPSF);
          if (part == 0) { v *= 0.125f; qs[t * 65 + lane] = v; } else ks[t * 65 + lane] = v;
        }
        DQ[part * 4096 + t * 64 + lane] = f2bf(v);
      }
    }
    __syncthreads();
  }
  float gk[4][4], qk[4][4];
#pragma unroll
  for (int a = 0; a < 4; ++a)
#pragma unroll
    for (int b = 0; b < 4; ++b) { gk[a][b] = 0.f; qk[a][b] = 0.f; }
  for (int d = 0; d < 64; ++d) {
    float x[4], y[4], z[4];
#pragma unroll
    for (int a = 0; a < 4; ++a) { x[a] = qs[(4 * ti + a) * 65 + d]; z[a] = ks[(4 * ti + a) * 65 + d]; y[a] = ks[(4 * tj + a) * 65 + d]; }
#pragma unroll
    for (int a = 0; a < 4; ++a)
#pragma unroll
      for (int b = 0; b < 4; ++b) { qk[a][b] += x[a] * y[b]; gk[a][b] += z[a] * y[b]; }
  }
  __syncthreads();
  u16* PR1 = (u16*)(p.ws + OFF_U);
#pragma unroll
  for (int dir = 0; dir < 2; ++dir) {
    u16* AQ = PR1 + ((size_t)(item * 2 + dir) * 2 + 1) * 4096;
#pragma unroll
    for (int a = 0; a < 4; ++a) {
      int ir = 4 * ti + a;
      int ip = dir ? 63 - ir : ir;
      float gi = gcs[dir * 64 + ip], bi = bes[dir * 64 + ip];
#pragma unroll
      for (int b = 0; b < 4; ++b) {
        int jr = 4 * tj + b;
        int jp = dir ? 63 - jr : jr;
        float e = __expf(gi - gcs[dir * 64 + jp]);
        float akk = (jp < ip) ? bi * gk[a][b] * e : 0.f;
        float aqk = (jp <= ip) ? qk[a][b] * e : 0.f;
        As[(dir * 64 + ip) * 64 + jp] = akk;
        AQ[ip * 64 + jp] = f2bf(aqk);
      }
    }
  }
  __syncthreads();
  if (wave < 2) {
    const float* A = As + wave * 4096;
    u16* T = PR1 + ((size_t)(item * 2 + wave) * 2 + 0) * 4096;
    float tc[64];
#pragma unroll
    for (int i = 0; i < 64; ++i) {
      float acc = (i == lane) ? 1.f : 0.f;
#pragma unroll
      for (int j4 = 0; j4 < (i + 3) / 4; ++j4) {
        float4 a = *(const float4*)(A + i * 64 + j4 * 4);
        if (j4 * 4 + 0 < i) acc -= a.x * tc[j4 * 4 + 0];
        if (j4 * 4 + 1 < i) acc -= a.y * tc[j4 * 4 + 1];
        if (j4 * 4 + 2 < i) acc -= a.z * tc[j4 * 4 + 2];
        if (j4 * 4 + 3 < i) acc -= a.w * tc[j4 * 4 + 3];
      }
      tc[i] = acc;
      T[i * 64 + lane] = f2bf(acc);
    }
  }
}

constexpr int SROW = 136;
constexpr int SIMG = 64 * SROW;

__device__ __forceinline__ bf16x8 frag_perm(const char* img, int row, int s, int q) {
  const char* b = img + row * SROW + s * 64 + q * 8;
  s16x4 lo = *(const s16x4*)(b), hi = *(const s16x4*)(b + 32);
  return (bf16x8){lo[0], lo[1], lo[2], lo[3], hi[0], hi[1], hi[2], hi[3]};
}
__device__ __forceinline__ bf16x8 frag_nat(const char* img, int row, int s, int q) {
  const char* b = img + row * SROW + s * 64 + q * 16;
  s16x4 lo = *(const s16x4*)(b), hi = *(const s16x4*)(b + 8);
  return (bf16x8){lo[0], lo[1], lo[2], lo[3], hi[0], hi[1], hi[2], hi[3]};
}
typedef __attribute__((ext_vector_type(4))) unsigned u32x4_t;
__device__ __forceinline__ bf16x8 acc_frag(const f32x4& x0, const f32x4& x1) {
  u32x4_t w = {pack2(x0[0], x0[1]), pack2(x0[2], x0[3]), pack2(x1[0], x1[1]), pack2(x1[2], x1[3])};
  return __builtin_bit_cast(bf16x8, w);
}
__device__ __forceinline__ uint4 img_ld(const u16* g, int gstride, int tid, int i) {
  int e = tid + 256 * i;
  return *(const uint4*)(g + (size_t)(e >> 3) * gstride + (e & 7) * 8);
}
__device__ __forceinline__ void img_st(char* img, uint4 v, int tid, int i, bool rev_rows, bool rev_cols) {
  int e = tid + 256 * i;
  int row = e >> 3, ch = e & 7;
  int drow = rev_rows ? 63 - row : row;
  if (rev_cols) {
    uint4 w;
    w.x = (v.w >> 16) | (v.w << 16); w.y = (v.z >> 16) | (v.z << 16);
    w.z = (v.y >> 16) | (v.y << 16); w.w = (v.x >> 16) | (v.x << 16);
    v = w; ch = 7 - ch;
  }
  char* d = img + drow * SROW + ch * 16;
  *(uint2*)d = make_uint2(v.x, v.y);
  *(uint2*)(d + 8) = make_uint2(v.z, v.w);
}
__device__ __forceinline__ uint4 imgt_ld(const u16* g, int gstride, int tid, int i) {
  int e = tid + 256 * i;
  return *(const uint4*)(g + (size_t)(e & 63) * gstride + (e >> 6) * 8);
}
__device__ __forceinline__ void imgt_st(char* img, uint4 v, int tid, int i, bool rev_rows) {
  int e = tid + 256 * i;
  int row = e & 63, ch = e >> 6;
  int ip = rev_rows ? 63 - row : row;
  unsigned w[4] = {v.x, v.y, v.z, v.w};
#pragma unroll
  for (int j = 0; j < 4; ++j) {
    *(u16*)(img + (ch * 8 + 2 * j) * SROW + ip * 2) = (u16)(w[j] & 0xffffu);
    *(u16*)(img + (ch * 8 + 2 * j + 1) * SROW + ip * 2) = (u16)(w[j] >> 16);
  }
}

__device__ void delta_scan(const Params& p, int l, int seq, int h, int dir, char* smem) {
  const int tid = otid(), lane = tid & 63, wave = tid >> 6;
  const int r = lane & 15, q = lane >> 4;
  char* iK = smem;
  char* iKT = smem + SIMG;
  char* iQ = smem + 2 * SIMG;
  char* iT = smem + 3 * SIMG;
  char* iA = smem + 4 * SIMG;
  char* iV = smem + 5 * SIMG;
  float* sgc = (float*)(smem + 6 * SIMG);
  float* sbe = sgc + 64;
  float* seg = sgc + 128;
  float* skd = sgc + 192;
  const int nch = seq_len(seq) / 64;
  const int ci0 = seq_tok0(seq) / 64;
  const int dvc = wave * 16 + r;
  f32x4 S[4];
  if (seq >= 16) {
    const float* s0 = p.in[4] + ((size_t)(((seq - 16) * 2 + l) * 2 + dir) * 4 + h) * 4096;
#pragma unroll
    for (int t = 0; t < 4; ++t)
#pragma unroll
      for (int i = 0; i < 4; ++i) S[t][i] = s0[(16 * t + 4 * q + i) * 64 + dvc];
  } else {
#pragma unroll
    for (int t = 0; t < 4; ++t) S[t] = (f32x4){0.f, 0.f, 0.f, 0.f};
  }
  u16* O = (u16*)(p.ws + OFF_BPRE) + (size_t)dir * NT * 256;
  uint4 pre[12];
  float preaux = 0.f;
  auto load_chunk = [&](int n) {
    const int cix = ci0 + (dir ? nch - 1 - n : n);
    const int itm = cix * 4 + h;
    const u16* DQ = (const u16*)(p.ws + OFF_DQKV) + (size_t)itm * 3 * 4096;
    const u16* PR = (const u16*)(p.ws + OFF_U) + (size_t)(itm * 2 + dir) * 2 * 4096;
    const float* aux = (const float*)(p.ws + OFF_DAUX) + (size_t)(itm * 2 + dir) * 128;
#pragma unroll
    for (int i = 0; i < 2; ++i) {
      pre[i] = img_ld(DQ, 64, tid, i);
      pre[2 + i] = img_ld(DQ + 4096, 64, tid, i);
      pre[4 + i] = imgt_ld(DQ + 4096, 64, tid, i);
      pre[6 + i] = imgt_ld(DQ + 8192, 64, tid, i);
      pre[8 + i] = img_ld(PR, 64, tid, i);
      pre[10 + i] = img_ld(PR + 4096, 64, tid, i);
    }
    if (tid < 128) preaux = aux[tid];
  };
  load_chunk(0);
  for (int n = 0; n < nch; ++n) {
    const int ci = ci0 + (dir ? nch - 1 - n : n);
    __syncthreads();
#pragma unroll
    for (int i = 0; i < 2; ++i) {
      img_st(iQ, pre[i], tid, i, dir, false);
      img_st(iK, pre[2 + i], tid, i, dir, false);
      imgt_st(iKT, pre[4 + i], tid, i, dir);
      imgt_st(iV, pre[6 + i], tid, i, dir);
      img_st(iT, pre[8 + i], tid, i, false, false);
      img_st(iA, pre[10 + i], tid, i, false, false);
    }
    if (tid < 128) sgc[tid] = preaux;
    if (tid < 64) {
      float glast = __int_as_float(__builtin_amdgcn_readlane(__float_as_int(preaux), 63));
      seg[tid] = __expf(preaux);
      skd[tid] = __expf(glast - preaux);
    }
    __syncthreads();
    if (n + 1 < nch) load_chunk(n + 1);
    const float gl = sgc[63];
    bf16x8 fK[4][2], fQ[4][2], fT[4][2];
    float4 eg4[4], be4[4], kd4[4];
    float vv[4][4];
#pragma unroll
    for (int m = 0; m < 4; ++m) {
      const int row = 16 * m + r;
      fK[m][0] = frag_perm(iK, row, 0, q); fK[m][1] = frag_perm(iK, row, 1, q);
      fQ[m][0] = frag_perm(iQ, row, 0, q); fQ[m][1] = frag_perm(iQ, row, 1, q);
      fT[m][0] = frag_perm(iT, row, 0, q); fT[m][1] = frag_perm(iT, row, 1, q);
      eg4[m] = *(const float4*)(seg + 16 * m + 4 * q);
      be4[m] = *(const float4*)(sbe + 16 * m + 4 * q);
      kd4[m] = *(const float4*)(skd + 16 * m + 4 * q);
      const s16x4 v4 = *(const s16x4*)(iV + dvc * SROW + (16 * m + 4 * q) * 2);
#pragma unroll
      for (int i = 0; i < 4; ++i) vv[m][i] = bf2f((u16)v4[i]);
    }
    bf16x8 sb0 = acc_frag(S[0], S[1]), sb1 = acc_frag(S[2], S[3]);
    f32x4 rr[4], qs_[4];
#pragma unroll
    for (int m = 0; m < 4; ++m) {
      f32x4 m1 = (f32x4){0.f, 0.f, 0.f, 0.f}, qq = m1;
      m1 = MFMA16(fK[m][0], sb0, m1); m1 = MFMA16(fK[m][1], sb1, m1);
      qq = MFMA16(fQ[m][0], sb0, qq); qq = MFMA16(fQ[m][1], sb1, qq);
      const float eg[4] = {eg4[m].x, eg4[m].y, eg4[m].z, eg4[m].w}, be[4] = {be4[m].x, be4[m].y, be4[m].z, be4[m].w};
#pragma unroll
      for (int i = 0; i < 4; ++i) {
        rr[m][i] = be[i] * (vv[m][i] - eg[i] * m1[i]);
        qs_[m][i] = eg[i] * qq[i];
      }
    }
    bf16x8 fA[4][2], fKT[4][2];
#pragma unroll
    for (int m = 0; m < 4; ++m) {
      const int row = 16 * m + r;
      fA[m][0] = frag_perm(iA, row, 0, q); fA[m][1] = frag_perm(iA, row, 1, q);
      fKT[m][0] = frag_perm(iKT, row, 0, q); fKT[m][1] = frag_perm(iKT, row, 1, q);
    }
    bf16x8 rb0 = acc_frag(rr[0], rr[1]), rb1 = acc_frag(rr[2], rr[3]);
    f32x4 vn[4];
#pragma unroll
    for (int m = 0; m < 4; ++m) {
      f32x4 a = (f32x4){0.f, 0.f, 0.f, 0.f};
      a = MFMA16(fT[m][0], rb0, a); a = MFMA16(fT[m][1], rb1, a);
      vn[m] = a;
    }
    bf16x8 vb0 = acc_frag(vn[0], vn[1]), vb1 = acc_frag(vn[2], vn[3]);
#pragma unroll
    for (int m = 0; m < 4; ++m) {
      f32x4 o = qs_[m];
      o = MFMA16(fA[m][0], vb0, o); o = MFMA16(fA[m][1], vb1, o);
      const float kd[4] = {kd4[m].x, kd4[m].y, kd4[m].z, kd4[m].w};
#pragma unroll
      for (int i = 0; i < 4; ++i) {
        int tr = 16 * m + 4 * q + i;
        int tg = ci * 64 + (dir ? 63 - tr : tr);
        O[(size_t)tg * 256 + h * 64 + dvc] = f2bf(o[i]);
        vn[m][i] *= kd[i];
      }
    }
    bf16x8 vd0 = acc_frag(vn[0], vn[1]), vd1 = acc_frag(vn[2], vn[3]);
    const float egl = __expf(gl);
#pragma unroll
    for (int t = 0; t < 4; ++t) {
      f32x4 a = S[t] * egl;
      a = MFMA16(fKT[t][0], vd0, a); a = MFMA16(fKT[t][1], vd1, a);
      S[t] = a;
    }
  }
  if (seq < 16) {
    float* o = p.out + OUT_DS + ((size_t)((seq * 2 + l) * 2 + dir) * 4 + h) * 4096;
#pragma unroll
    for (int t = 0; t < 4; ++t)
#pragma unroll
      for (int i = 0; i < 4; ++i) o[(16 * t + 4 * q + i) * 64 + dvc] = S[t][i];
  }
}

__device__ void mlstm_scan(const Params& p, int l, int seq, int h, int dir, char* smem) {
  const int tid = otid(), lane = tid & 63, wave = tid >> 6;
  const int r = lane & 15, q = lane >> 4;
  char* iQ = smem;
  char* iQK = smem + SIMG;
  char* iKT = smem + 2 * SIMG;
  char* iVT = smem + 3 * SIMG;
  float* sb = (float*)(smem + 4 * SIMG);
  float* sa = sb + 64;
  float* spm = sb + 128;
  float* sea = sb + 192;
  float* rw = sb + 256 + (otid() >> 6) * 256;
  const int nch = seq_len(seq) / 64;
  const int ci0 = seq_tok0(seq) / 64;
  const int dvc = wave * 16 + r;
  f32x4 C[4], N[4];
  float ms;
  if (seq >= 16) {
    size_t sidx = (size_t)(((seq - 16) * 2 + l) * 2 + dir) * 4 + h;
    const float* c0 = p.in[5] + sidx * 4096;
    const float* n0 = p.in[6] + sidx * 64;
    ms = p.in[7][sidx];
#pragma unroll
    for (int t = 0; t < 4; ++t)
#pragma unroll
      for (int i = 0; i < 4; ++i) {
        C[t][i] = c0[(16 * t + 4 * q + i) * 64 + dvc];
        N[t][i] = (r == 0) ? n0[16 * t + 4 * q + i] : 0.f;
      }
  } else {
    ms = 0.f;
#pragma unroll
    for (int t = 0; t < 4; ++t) { C[t] = (f32x4){0.f, 0.f, 0.f, 0.f}; N[t] = C[t]; }
  }
  const short one_bf = (r == 0) ? (short)0x3f80 : (short)0;
  const bf16x8 ones = (bf16x8){one_bf, one_bf, one_bf, one_bf, one_bf, one_bf, one_bf, one_bf};
  u16* O = (u16*)(p.ws + OFF_MOM) + (size_t)dir * NT * 256;
  const u16* CQ = (const u16*)(p.ws + OFF_CQKV);
  uint4 pre[8];
  float preaux = 0.f;
  auto load_chunk = [&](int n) {
    const int cix = ci0 + (dir ? nch - 1 - n : n);
    const int itm = cix * 4 + h;
    const float* aux = (const float*)(p.ws + OFF_MAUX) + (size_t)(itm * 2 + dir) * 192;
    const u16* cq = CQ + (size_t)cix * 64 * 768 + h * 64;
#pragma unroll
    for (int i = 0; i < 2; ++i) {
      pre[i] = img_ld(cq, 768, tid, i);
      pre[2 + i] = img_ld((const u16*)(p.ws + OFF_MQK) + (size_t)itm * 4096, 64, tid, i);
      pre[4 + i] = imgt_ld(cq + 256, 768, tid, i);
      pre[6 + i] = imgt_ld(cq + 512, 768, tid, i);
    }
    if (tid < 192) preaux = aux[tid];
  };
  load_chunk(0);
  for (int n = 0; n < nch; ++n) {
    const int ci = ci0 + (dir ? nch - 1 - n : n);
    __syncthreads();
#pragma unroll
    for (int i = 0; i < 2; ++i) {
      img_st(iQ, pre[i], tid, i, dir, false);
      img_st(iQK, pre[2 + i], tid, i, dir, dir);
      imgt_st(iKT, pre[4 + i], tid, i, dir);
      imgt_st(iVT, pre[6 + i], tid, i, dir);
    }
    if (tid < 192) sb[tid] = preaux;
    if (tid >= 64 && tid < 128) sea[tid - 64] = __expf(preaux);
    __syncthreads();
    if (n + 1 < nch) load_chunk(n + 1);
    const float blast = sb[63], pmlast = spm[63];
    {
      float brow = sb[lane];
      float mtl = fmaxf(brow + ms, brow + spm[lane]);
      rw[lane] = __expf(brow + ms - mtl);
      rw[64 + lane] = __expf(-mtl);
      rw[128 + lane] = __expf(brow - mtl);
    }
    __builtin_amdgcn_wave_barrier();
    float cf[2][8];
#pragma unroll
    for (int s2 = 0; s2 < 2; ++s2) {
      float4 c0 = *(const float4*)(sea + 32 * s2 + 8 * q), c1 = *(const float4*)(sea + 32 * s2 + 8 * q + 4);
      cf[s2][0] = c0.x; cf[s2][1] = c0.y; cf[s2][2] = c0.z; cf[s2][3] = c0.w;
      cf[s2][4] = c1.x; cf[s2][5] = c1.y; cf[s2][6] = c1.z; cf[s2][7] = c1.w;
    }
    bf16x8 cb0 = acc_frag(C[0], C[1]), cb1 = acc_frag(C[2], C[3]);
    bf16x8 nb0 = acc_frag(N[0], N[1]), nb1 = acc_frag(N[2], N[3]);
    bf16x8 vf0 = frag_nat(iVT, dvc, 0, q), vf1 = frag_nat(iVT, dvc, 1, q);
#pragma unroll
    for (int m = 0; m < 4; ++m) {
      int row = 16 * m + r;
      f32x4 qc = (f32x4){0.f, 0.f, 0.f, 0.f}, qn = qc;
      bf16x8 a0 = frag_perm(iQ, row, 0, q), a1 = frag_perm(iQ, row, 1, q);
      qc = MFMA16(a0, cb0, qc); qc = MFMA16(a1, cb1, qc);
      qn = MFMA16(a0, nb0, qn); qn = MFMA16(a1, nb1, qn);
      const float rfA = rw[128 + row];
      bf16x8 sf[2];
#pragma unroll
      for (int s2 = 0; s2 < 2; ++s2) {
        bf16x8 qkf = frag_nat(iQK, row, s2, q);
        float e[8];
#pragma unroll
        for (int j = 0; j < 8; ++j) {
          int jp = 32 * s2 + 8 * q + j;
          e[j] = (jp <= row) ? bf2f((u16)qkf[j]) * rfA * cf[s2][j] : 0.f;
        }
        u32x4_t w = {pack2(e[0], e[1]), pack2(e[2], e[3]), pack2(e[4], e[5]), pack2(e[6], e[7])};
        sf[s2] = __builtin_bit_cast(bf16x8, w);
      }
      const float4 wi4 = *(const float4*)(rw + 16 * m + 4 * q);
      const float4 em4 = *(const float4*)(rw + 64 + 16 * m + 4 * q);
      const float wi[4] = {wi4.x, wi4.y, wi4.z, wi4.w}, em[4] = {em4.x, em4.y, em4.z, em4.w};
      f32x4 num, den;
#pragma unroll
      for (int i = 0; i < 4; ++i) { num[i] = wi[i] * qc[i]; den[i] = wi[i] * qn[i]; }
      num = MFMA16(sf[0], vf0, num); num = MFMA16(sf[1], vf1, num);
      den = MFMA16(sf[0], ones, den); den = MFMA16(sf[1], ones, den);
#pragma unroll
      for (int i = 0; i < 4; ++i) {
        int tr = 16 * m + 4 * q + i;
        float dr = shl_(den[i], q * 16);
        float hv = num[i] * __builtin_amdgcn_rcpf(fmaxf(fabsf(dr), em[i]));
        int tg = ci * 64 + (dir ? 63 - tr : tr);
        O[(size_t)tg * 256 + h * 64 + dvc] = f2bf(hv);
      }
    }
    float mnew = fmaxf(blast + ms, blast + pmlast);
    float dec = __expf(blast + ms - mnew);
    const float ebl = __expf(blast - mnew);
    bf16x8 wv[2], wo[2];
#pragma unroll
    for (int s2 = 0; s2 < 2; ++s2) {
      bf16x8 vf = s2 ? vf1 : vf0;
      float wk[8], wvv[8];
#pragma unroll
      for (int j = 0; j < 8; ++j) { wk[j] = ebl * cf[s2][j]; wvv[j] = wk[j] * bf2f((u16)vf[j]); }
      u32x4_t w1 = {pack2(wvv[0], wvv[1]), pack2(wvv[2], wvv[3]), pack2(wvv[4], wvv[5]), pack2(wvv[6], wvv[7])};
      u32x4_t w2 = {pack2(wk[0], wk[1]), pack2(wk[2], wk[3]), pack2(wk[4], wk[5]), pack2(wk[6], wk[7])};
      if (r != 0) w2 = (u32x4_t){0u, 0u, 0u, 0u};
      wv[s2] = __builtin_bit_cast(bf16x8, w1);
      wo[s2] = __builtin_bit_cast(bf16x8, w2);
    }
#pragma unroll
    for (int t = 0; t < 4; ++t) {
      int row = 16 * t + r;
      bf16x8 k0 = frag_nat(iKT, row, 0, q), k1 = frag_nat(iKT, row, 1, q);
      f32x4 c = C[t] * dec, nn = N[t] * dec;
      c = MFMA16(k0, wv[0], c); c = MFMA16(k1, wv[1], c);
      nn = MFMA16(k0, wo[0], nn); nn = MFMA16(k1, wo[1], nn);
      C[t] = c; N[t] = nn;
    }
    __builtin_amdgcn_wave_barrier();
    ms = mnew;
  }
  if (seq < 16) {
    size_t sidx = (size_t)((seq * 2 + l) * 2 + dir) * 4 + h;
    float* oc = p.out + OUT_MC + sidx * 4096;
#pragma unroll
    for (int t = 0; t < 4; ++t)
#pragma unroll
      for (int i = 0; i < 4; ++i) oc[(16 * t + 4 * q + i) * 64 + dvc] = C[t][i];
    if (wave == 0 && r == 0) {
#pragma unroll
      for (int t = 0; t < 4; ++t)
#pragma unroll
        for (int i = 0; i < 4; ++i) p.out[OUT_MN + sidx * 64 + 16 * t + 4 * q + i] = N[t][i];
    }
    if (tid == 0) p.out[OUT_MM + sidx] = ms;
  }
}

__device__ void attn_item(const Params& p, int l, int seq, int head, int qb, char* smem) {
  const int tid = otid(), lane = tid & 63, wave = tid >> 6;
  const int r32 = lane & 31, hh = lane >> 5;
  const int qg = wave >> 1, c = wave & 1;
  const int Lk = seq_lk(seq);
  const int ntile = Lk / 64;
  const size_t kr0 = krow0(seq, head);
  const u16* Kb = (const u16*)(p.ws + OFF_K) + kr0 * 128;
  const u16* Vb = (const u16*)(p.ws + OFF_VT) + kr0 * 128;
  u16* Q = (u16*)(p.ws + OFF_Q);
  const int tq = seq_tok0(seq) + qb * 64 + qg * 32 + r32;
  bf16x8 qf[4];
#pragma unroll
  for (int ks = 0; ks < 4; ++ks) qf[ks] = *(const bf16x8*)(Q + (size_t)tq * 512 + head * 128 + c * 64 + ks * 16 + hh * 8);
  f32x16 O[4];
#pragma unroll
  for (int d = 0; d < 4; ++d)
#pragma unroll
    for (int i = 0; i < 16; ++i) O[d][i] = 0.f;
  float mrun = -1.0e30f, lrun = 0.f;

  const unsigned koff0 = (unsigned)((wave * 4 + (lane >> 4)) * 256 + (((lane & 15) ^ ((wave * 4 + (lane >> 4)) & 15)) * 16));
  const unsigned voff0 = (unsigned)((wave * 8 + (lane >> 3)) * Lk * 2 + (((lane & 7) ^ ((wave * 4 + (lane >> 4)) & 7)) * 16));
  const unsigned ldst0 = (unsigned)(wave * 1024 + lane * 16);
  uint4 sg0, sg1, sg2, sg3;
  auto issue = [&](int kt, int buf) {
    char* sK = smem + buf * 32768 + ldst0;
    const unsigned ko = koff0 + (unsigned)kt * 16384u;
#pragma unroll
    for (int i = 0; i < 4; ++i) glds16((const char*)Kb + (ko + (unsigned)(i * 4096)), sK + i * 4096);
  };
#define VLOAD(kt_) do { const unsigned vo_ = voff0 + (unsigned)(kt_) * 128u; const char* vb_ = (const char*)Vb; \
    sg0 = *(const uint4*)(vb_ + vo_); sg1 = *(const uint4*)(vb_ + (vo_ + (unsigned)(64 * Lk))); \
    sg2 = *(const uint4*)(vb_ + (vo_ + (unsigned)(128 * Lk))); sg3 = *(const uint4*)(vb_ + (vo_ + (unsigned)(192 * Lk))); } while (0)
#define VSTORE(buf_) do { char* sV_ = smem + (buf_) * 32768 + 16384 + ldst0; \
    *(uint4*)(sV_) = sg0; *(uint4*)(sV_ + 4096) = sg1; *(uint4*)(sV_ + 8192) = sg2; *(uint4*)(sV_ + 12288) = sg3; } while (0)
  __syncthreads();
  issue(0, 0);
  VLOAD(0);
  VSTORE(0);
  for (int kt = 0; kt < ntile; ++kt) {
    wait_vm0();
    __syncthreads();
    if (kt + 1 < ntile) { issue(kt + 1, (kt + 1) & 1); VLOAD(kt + 1); }
    const unsigned bufo = (unsigned)(kt & 1) * 32768u;
    f32x16 Sx[2];
#pragma unroll
    for (int half = 0; half < 2; ++half) {
      const unsigned kx = bufo + (unsigned)(32 * half + r32) * 256u + (unsigned)c * 128u, kswz = (unsigned)(r32 & 15) << 4;
      bf16x8 ka[4];
#pragma unroll
      for (int ks = 0; ks < 4; ++ks) ka[ks] = *(const bf16x8*)(smem + ((kx + (unsigned)((2 * ks + hh) * 16)) ^ kswz));
#pragma unroll
      for (int i = 0; i < 16; ++i) Sx[half][i] = 0.f;
#pragma unroll
      for (int ks = 0; ks < 4; ++ks) Sx[half] = MFMA32(ka[ks], qf[ks], Sx[half]);
    }
#pragma unroll
    for (int half = 0; half < 2; ++half) {
      bf16x8 pf[2];
      bf16x8 vfr[4][2];
#pragma unroll
      for (int d = 0; d < 4; ++d) {
        const int row = 32 * d + r32;
        const unsigned vswz = (unsigned)((row >> 1) & 7) << 4;
        const unsigned vx = bufo + 16384u + (unsigned)row * 128u + 16u * (unsigned)hh + (unsigned)half * 64u;
#pragma unroll
        for (int s2 = 0; s2 < 2; ++s2) vfr[d][s2] = *(const bf16x8*)(smem + ((vx + (unsigned)(s2 * 32)) ^ vswz));
      }
      __builtin_amdgcn_sched_barrier(0);
      float mx = Sx[half][0];
#pragma unroll
      for (int i = 1; i < 16; ++i) mx = fmaxf(mx, Sx[half][i]);
      mx = fmaxf(mx, shx(mx, 32, lane));
      float mnew = fmaxf(mrun, mx);
      const bool grow = __builtin_amdgcn_ballot_w64(mnew > mrun) != 0ull;
      float ps = 0.f;
#pragma unroll
      for (int i = 0; i < 16; ++i) { float e = __builtin_amdgcn_exp2f(Sx[half][i] - mnew); Sx[half][i] = e; ps += e; }
      if (grow) {
        float alpha = __builtin_amdgcn_exp2f(mrun - mnew);
        mrun = mnew;
        lrun *= alpha;
#pragma unroll
        for (int d = 0; d < 4; ++d)
#pragma unroll
          for (int i = 0; i < 16; ++i) O[d][i] *= alpha;
      }
      lrun += ps;
#pragma unroll
      for (int s2 = 0; s2 < 2; ++s2) {
        u32x4_t w = {pack2(Sx[half][8 * s2], Sx[half][8 * s2 + 1]), pack2(Sx[half][8 * s2 + 2], Sx[half][8 * s2 + 3]),
                     pack2(Sx[half][8 * s2 + 4], Sx[half][8 * s2 + 5]), pack2(Sx[half][8 * s2 + 6], Sx[half][8 * s2 + 7])};
        pf[s2] = __builtin_bit_cast(bf16x8, w);
      }
      __builtin_amdgcn_sched_barrier(0);
#pragma unroll
      for (int d = 0; d < 4; ++d)
#pragma unroll
        for (int s2 = 0; s2 < 2; ++s2) O[d] = MFMA32(vfr[d][s2], pf[s2], O[d]);
    }
    if (kt + 1 < ntile) VSTORE((kt + 1) & 1);
  }
  const int tid2 = otid();
  const int lane2 = tid2 & 63, r32b = lane2 & 31, hhb = lane2 >> 5, qgb = tid2 >> 7, cb = (tid2 >> 6) & 1;
  const int tqb = seq_tok0(seq) + qb * 64 + qgb * 32 + r32b;
  float lsum = lrun + shx(lrun, 32, lane2);
  const int l2 = *(volatile LAS int*)(LAS int*)(smem + LDS_CTL + 4);
  const float lam = ((const float*)(p.ws + OFF_LAM))[l2];
  const float lam_init = l2 == 0 ? 0.2f : 0.35550907f;
  float inv = (cb == 0 ? 1.f : lam) / lsum;
  float* xch = (float*)smem + qgb * (32 * 132) + r32b * 132;
  __syncthreads();
  if (cb == 1) {
#pragma unroll
    for (int d = 0; d < 4; ++d)
#pragma unroll
      for (int g = 0; g < 4; ++g) {
        int dv = 32 * d + 8 * g + 4 * hhb;
        *(float4*)(xch + dv) = make_float4(O[d][4 * g] * inv, O[d][4 * g + 1] * inv, O[d][4 * g + 2] * inv, O[d][4 * g + 3] * inv);
      }
  }
  __syncthreads();
  if (cb == 0) {
    float ss = 0.f;
#pragma unroll
    for (int d = 0; d < 4; ++d)
#pragma unroll
      for (int g = 0; g < 4; ++g) {
        int dv = 32 * d + 8 * g + 4 * hhb;
        float4 o1 = *(const float4*)(xch + dv);
        float v0 = O[d][4 * g] * inv - o1.x, v1 = O[d][4 * g + 1] * inv - o1.y;
        float v2 = O[d][4 * g + 2] * inv - o1.z, v3 = O[d][4 * g + 3] * inv - o1.w;
        O[d][4 * g] = v0; O[d][4 * g + 1] = v1; O[d][4 * g + 2] = v2; O[d][4 * g + 3] = v3;
        ss += v0 * v0 + v1 * v1 + v2 * v2 + v3 * v3;
      }
    ss += shx(ss, 32, lane2);
    float rs = rsqrtf(ss * (1.f / 128.f) + EPSF) * (1.f - lam_init);
    const float* ag = p.in[18] + l2 * 128;
#pragma unroll
    for (int d = 0; d < 4; ++d)
#pragma unroll
      for (int g = 0; g < 4; ++g) {
        int dv = 32 * d + 8 * g + 4 * hhb;
        float4 gg = *(const float4*)(ag + dv);
        uint2 o;
        o.x = pack2(O[d][4 * g + 0] * rs * gg.x, O[d][4 * g + 1] * rs * gg.y);
        o.y = pack2(O[d][4 * g + 2] * rs * gg.z, O[d][4 * g + 3] * rs * gg.w);
        *(uint2*)(Q + (size_t)tqb * 512 + head * 128 + dv) = o;
      }
  }
}

__device__ void merge_phase(const Params& p, int l, int bid, int nb) {
  const int tid_ = otid();
  const int wave = tid_ >> 6, lane = tid_ & 63;
  const u16* Od = (const u16*)(p.ws + OFF_BPRE);
  const u16* Om = (const u16*)(p.ws + OFF_MOM);
  const u16* BG = (const u16*)(p.ws + OFF_BG);
  const u16* CO = (const u16*)(p.ws + OFF_CO);
  u16* cat2 = (u16*)(p.ws + OFF_U);
  const float* dg = p.in[22] + l * 64;
  const float* mg = p.in[24] + l * 64;
  for (int t = bid * 4 + wave; t < NT; t += nb * 4) {
    int c = lane * 4;
    uint2 a = *(const uint2*)(Od + (size_t)t * 256 + c), b = *(const uint2*)(Od + (size_t)(NT + t) * 256 + c);
    uint2 gt = *(const uint2*)(BG + (size_t)t * 256 + c);
    float v[4] = {bf2f(a.x & 0xffff) + bf2f(b.x & 0xffff), bf2f(a.x >> 16) + bf2f(b.x >> 16),
                  bf2f(a.y & 0xffff) + bf2f(b.y & 0xffff), bf2f(a.y >> 16) + bf2f(b.y >> 16)};
    float g[4] = {bf2f(gt.x & 0xffff), bf2f(gt.x >> 16), bf2f(gt.y & 0xffff), bf2f(gt.y >> 16)};
    float ss = v[0] * v[0] + v[1] * v[1] + v[2] * v[2] + v[3] * v[3];
#pragma unroll
    for (int o = 8; o > 0; o >>= 1) ss += shx(ss, o, lane);
    float rs = rsqrtf(ss * (1.f / 64.f) + EPSF);
    float4 w = *(const float4*)(dg + (c & 63));
    uint2 o;
    o.x = pack2(v[0] * rs * w.x * siluf(g[0]), v[1] * rs * w.y * siluf(g[1]));
    o.y = pack2(v[2] * rs * w.z * siluf(g[2]), v[3] * rs * w.w * siluf(g[3]));
    *(uint2*)(cat2 + (size_t)t * 512 + c) = o;
    a = *(const uint2*)(Om + (size_t)t * 256 + c); b = *(const uint2*)(Om + (size_t)(NT + t) * 256 + c);
    gt = *(const uint2*)(CO + (size_t)t * 256 + c);
    float v2[4] = {bf2f(a.x & 0xffff) + bf2f(b.x & 0xffff), bf2f(a.x >> 16) + bf2f(b.x >> 16),
                   bf2f(a.y & 0xffff) + bf2f(b.y & 0xffff), bf2f(a.y >> 16) + bf2f(b.y >> 16)};
    float g2[4] = {bf2f(gt.x & 0xffff), bf2f(gt.x >> 16), bf2f(gt.y & 0xffff), bf2f(gt.y >> 16)};
    ss = v2[0] * v2[0] + v2[1] * v2[1] + v2[2] * v2[2] + v2[3] * v2[3];
#pragma unroll
    for (int o2 = 8; o2 > 0; o2 >>= 1) ss += shx(ss, o2, lane);
    rs = rsqrtf(ss * (1.f / 64.f) + EPSF);
    w = *(const float4*)(mg + (c & 63));
    o.x = pack2(v2[0] * rs * w.x * sigmf(g2[0]), v2[1] * rs * w.y * sigmf(g2[1]));
    o.y = pack2(v2[2] * rs * w.z * sigmf(g2[2]), v2[3] * rs * w.w * sigmf(g2[3]));
    *(uint2*)(cat2 + (size_t)t * 512 + 256 + c) = o;
  }
}

__device__ void final_norm(const Params& p, int bid, int nb) {
  const int tid_ = otid();
  const int wave = tid_ >> 6, lane = tid_ & 63;
  const float* g = p.in[27];
  for (int t = bid * 4 + wave; t < NT; t += nb * 4) {
    float* x = p.out + (size_t)t * DM;
    float4 v[4];
    float ss = 0.f;
#pragma unroll
    for (int i = 0; i < 4; ++i) {
      v[i] = *(const float4*)(x + i * 256 + lane * 4);
      ss += v[i].x * v[i].x + v[i].y * v[i].y + v[i].z * v[i].z + v[i].w * v[i].w;
    }
    ss = wave_sum(ss, lane);
    float rs = rsqrtf(ss * (1.f / 1024.f) + EPSF);
#pragma unroll
    for (int i = 0; i < 4; ++i) {
      float4 gg = *(const float4*)(g + i * 256 + lane * 4);
      float4 o = make_float4(v[i].x * rs * gg.x, v[i].y * rs * gg.y, v[i].z * rs * gg.z, v[i].w * rs * gg.w);
      *(float4*)(x + i * 256 + lane * 4) = o;
    }
  }
}

__device__ void mixer_queue(const Params& p, int l, char* smem, int xcc) {
  int& s_item = *(int*)(smem + LDS_CTL);
  if (otid() == 0) *(volatile LAS int*)(LAS int*)(smem + LDS_CTL + 4) = l;
#pragma unroll 1
  for (int qi = 0; qi < 8; ++qi) {
    const int qx = (xcc + qi) & 7;
    unsigned* cnt = (unsigned*)(p.ws + OFF_CNT) + __builtin_amdgcn_readfirstlane(l * 8 + qx);
    for (;;) {
      __syncthreads();
      if (otid() == 0) s_item = (int)atomicAdd(cnt, 1u);
      __syncthreads();
      int u = __builtin_amdgcn_readfirstlane(s_item);
      if (u >= 200) break;
      int kind, seq, a1, a2;
      if (u < 8) { int idx = qx * 4 + (u >> 1); kind = u & 1; seq = 16 + (idx >> 3); a1 = (idx >> 1) & 3; a2 = idx & 1; }
      else if (u < 136) { int j = u - 8; int pair = 2 * qx + (j >> 6); kind = 2; seq = 16 + (pair >> 2); a1 = pair & 3; a2 = j & 63; }
      else if (u < 168) { int g = qx * 32 + (u - 136); int idx = g >> 1; kind = g & 1; seq = idx >> 3; a1 = (idx >> 1) & 3; a2 = idx & 1; }
      else { int g = qx * 32 + (u - 168); kind = 2; seq = g >> 4; a1 = (g >> 2) & 3; a2 = g & 3; }
      if (kind == 0) delta_scan(p, l, seq, a1, a2, smem);
      else if (kind == 1) mlstm_scan(p, l, seq, a1, a2, smem);
      else attn_item(p, l, seq, a1, a2, smem);
    }
  }
}

__global__ void __launch_bounds__(256, 2) mega(Params p0) {
  extern __shared__ __attribute__((aligned(16))) char smem[];
  const int bid = blockIdx.x, nb = gridDim.x;
  if (threadIdx.x == 0) { *(volatile LAS unsigned*)(LAS unsigned*)(smem + LDS_CTL + 8) = 0u; *(volatile LAS unsigned*)(LAS unsigned*)(smem + LDS_CTL + 12) = 0u; }
  __syncthreads();
  const XcdBarrier xb = xcd_barrier_post((unsigned*)(p0.ws + OFF_BAR), (volatile LAS unsigned*)(LAS unsigned*)(smem + LDS_CTL + 8));
  if (p0.rep[3] < 0) cg::this_grid().sync();

#pragma unroll 1
  for (int ph = 0; ph < 20; ++ph) {
    const Params& p = p0;
    const int l = ph < 10 ? 0 : 1;
    const int k = ph == 0 ? -1 : (ph == 19 ? 9 : (ph - 1) % 9);
    switch (k) {
      case -1:
        for (int t = bid; t < 192; t += nb) mod_task(p, t, smem);
        if (bid == nb - 1) misc_task(p);
        wconv_job(p.in[14], (u16*)(p.ws + OFF_WIN), 1024, INW, INP, 1, smem, bid, nb);
        break;
      case 0:
        norm_phase(p, l, 0, bid, nb);
        cache_conv(p, l, smem, bid, nb);
        break;
      case 1:
        gemm_phase<EPI_IN>(p, l, (const u16*)(p.ws + OFF_U), 1024, (const u16*)(p.ws + OFF_U), 1024, 1 << 30,
                           (const u16*)(p.ws + OFF_WIN), 1024, INP / 128, smem, bid, nb);
        break;
      case 2:
        for (int it = bid; it < 1280; it += nb) prep_item(p, l, it >> 2, it & 3, smem);
        break;
      case 3:
        mixer_queue(p, l, smem, (int)(xb.x & 7u));
        break;
      case 4:
        merge_phase(p, l, bid, nb);
        wconv_job(p.in[16] + (size_t)l * 1024 * 1024, (u16*)(p.ws + OFF_WOUT), 1024, 1024, 1024, 0, smem, bid, nb);
        wconv_job(p.in[25] + (size_t)l * 1024 * 2 * FF, (u16*)(p.ws + OFF_WGU), 1024, 2 * FF, 2 * FF, 2, smem, bid, nb);
        wconv_job(p.in[26] + (size_t)l * FF * 1024, (u16*)(p.ws + OFF_WDN), FF, 1024, 1024, 0, smem, bid, nb);
        if (l == 0) wconv_job(p.in[14] + (size_t)1024 * INW, (u16*)(p.ws + OFF_WIN), 1024, INW, INP, 1, smem, bid, nb);
        break;
      case 5:
        gemm_phase<EPI_RES1>(p, l, (const u16*)(p.ws + OFF_Q), 512, (const u16*)(p.ws + OFF_U), 512, 512,
                             (const u16*)(p.ws + OFF_WOUT), 1024, 8, smem, bid, nb);
        break;
      case 6:
        norm_phase(p, l, 1, bid, nb);
        break;
      case 7:
        gemm_phase_big<EPI_SWIGLU>(p, l, (const u16*)(p.ws + OFF_U), 1024, (const u16*)(p.ws + OFF_WGU), 1024, 2 * FF / 128, smem, bid, nb);
        break;
      case 8:
        gemm_phase<EPI_RES2>(p, l, (const u16*)(p.ws), FF, (const u16*)(p.ws), FF, 1 << 30,
                             (const u16*)(p.ws + OFF_WDN), FF, 8, smem, bid, nb);
        break;
      default:
        final_norm(p, bid, nb);
        break;
    }
    if (ph < 19) xcd_barrier(xb);
  }
}

extern "C" void kernel_launch(void* const* d_in, const int* in_sizes, int n_in, void* d_out, int out_size,
                              void* d_ws, size_t ws_size, hipStream_t stream) {
  static int grid_blocks = 0;
  if (!grid_blocks) {
    int dev = 0, cus = 0, per_cu = 0;
    (void)hipGetDevice(&dev);
    (void)hipDeviceGetAttribute(&cus, hipDeviceAttributeMultiprocessorCount, dev);
    (void)hipFuncSetAttribute((const void*)mega, hipFuncAttributeMaxDynamicSharedMemorySize, LDS_BYTES);
    (void)hipOccupancyMaxActiveBlocksPerMultiprocessor(&per_cu, mega, 256, LDS_BYTES);
    if (per_cu > 2) per_cu = 2;
    if (per_cu < 1) per_cu = 1;
    grid_blocks = cus * per_cu;
  }
  if (ws_size < WS_NEED) { fprintf(stderr, "workspace too small: %zu < %zu\n", ws_size, (size_t)WS_NEED); return; }
  Params p{};
  for (int i = 0; i < 28; ++i) p.in[i] = (const float*)d_in[i];
  p.out = (float*)d_out;
  p.ws = (char*)d_ws;
  p.rep[0] = REP0; p.rep[1] = REP1; p.rep[2] = REP2; p.rep[3] = REP3;
  (void)hipMemsetAsync((char*)d_ws + OFF_BAR, 0, (size_t)XCD_BAR_WORDS_C * 4, stream);
  void* args[] = {&p};
  hipError_t e = hipLaunchCooperativeKernel((void*)mega, dim3(grid_blocks), dim3(256), args, LDS_BYTES, stream);
  if (e != hipSuccess) fprintf(stderr, "cooperative launch failed: %s (grid %d)\n", hipGetErrorString(e), grid_blocks);
}
```

```cpp
#include <hip/hip_runtime.h>
#include <hip/hip_cooperative_groups.h>
#include <cstdio>
namespace cg = cooperative_groups;

typedef __attribute__((ext_vector_type(8))) short bf16x8;
typedef __attribute__((ext_vector_type(4))) short s16x4;
typedef __attribute__((ext_vector_type(4))) float f32x4;
typedef __attribute__((ext_vector_type(16))) float f32x16;
typedef unsigned short u16;

#define MFMA16(a, b, c) __builtin_amdgcn_mfma_f32_16x16x32_bf16((a), (b), (c), 0, 0, 0)
#define MFMA32(a, b, c) __builtin_amdgcn_mfma_f32_32x32x16_bf16((a), (b), (c), 0, 0, 0)

constexpr int DM = 1024;
constexpr int NT = 20480;
constexpr int NTC = 4096;
constexpr int INW = 3616;
constexpr int INP = 3712;
constexpr int FF = 2816;
constexpr float EPSF = 1e-6f;
constexpr float LOG2E = 1.4426950408889634f;
constexpr int LDS_CTL = 73728;
constexpr int LDS_BYTES = LDS_CTL + 16;
constexpr int XCD_BAR_WORDS_C = 3456;

constexpr size_t OFF_Q = 0;
constexpr size_t OFF_K = OFF_Q + (size_t)NT * 512 * 2;
constexpr size_t OFF_VT = OFF_K + (size_t)90112 * 128 * 2;
constexpr size_t OFF_BPRE = OFF_VT + (size_t)90112 * 128 * 2;
constexpr size_t OFF_BG = OFF_BPRE + (size_t)NT * 768 * 2;
constexpr size_t OFF_CQKV = OFF_BG + (size_t)NT * 256 * 2;
constexpr size_t OFF_CO = OFF_CQKV + (size_t)NT * 768 * 2;
constexpr size_t OFF_GATE = OFF_CO + (size_t)NT * 256 * 2;
constexpr size_t OFF_U = OFF_GATE + (size_t)NT * 32 * 4;
constexpr size_t OFF_P2 = OFF_U + (size_t)NT * 1024 * 2;
constexpr size_t OFF_MOM = OFF_P2 + (size_t)NT * 1024 * 2;
constexpr size_t OFF_SMALL = OFF_MOM + (size_t)NT * 512 * 2;
constexpr size_t OFF_MODV = OFF_SMALL;
constexpr size_t OFF_ROPE = OFF_MODV + 2 * 5 * 6144 * 4;
constexpr size_t OFF_LAM = OFF_ROPE + 1024 * 8;
constexpr size_t OFF_CNT = OFF_LAM + 64;
constexpr size_t OFF_DAUX = OFF_CNT + 64;
constexpr size_t OFF_MAUX = OFF_DAUX + (size_t)2560 * 128 * 4;
constexpr size_t OFF_BAR = OFF_MAUX + (size_t)2560 * 192 * 4;
constexpr size_t WS_NEED = OFF_BAR + (size_t)XCD_BAR_WORDS_C * 4;
constexpr size_t OFF_WIN = OFF_P2;
constexpr size_t OFF_WOUT = OFF_WIN + (size_t)INP * 1024 * 2;
constexpr size_t OFF_WGU = OFF_WOUT + (size_t)1024 * 1024 * 2;
constexpr size_t OFF_WDN = OFF_WGU + (size_t)2 * FF * 1024 * 2;
constexpr size_t OFF_DQKV = OFF_P2;
constexpr size_t OFF_MQK = OFF_P2 + (size_t)1280 * 3 * 4096 * 2;

constexpr size_t OUT_NK = (size_t)NT * 1024;
constexpr size_t OUT_NV = OUT_NK + 4194304;
constexpr size_t OUT_DS = OUT_NV + 4194304;
constexpr size_t OUT_MC = OUT_DS + 1048576;
constexpr size_t OUT_MN = OUT_MC + 1048576;
constexpr size_t OUT_MM = OUT_MN + 16384;

struct Params {
  const float* in[28];
  float* out;
  char* ws;
  int rep[4];
};
constexpr int REP0 = 1, REP1 = 1, REP2 = 1, REP3 = 1;

typedef __attribute__((ext_vector_type(2))) float f32x2_t;
typedef __attribute__((ext_vector_type(2))) __bf16 bf16x2_t;
__device__ __forceinline__ unsigned pack2(float a, float b) {
  f32x2_t v = {a, b};
  bf16x2_t h = __builtin_convertvector(v, bf16x2_t);
  return __builtin_bit_cast(unsigned, h);
}
__device__ __forceinline__ u16 f2bf(float f) { return (u16)(pack2(f, 0.f) & 0xffffu); }
__device__ __forceinline__ float bf2f(u16 h) { return __uint_as_float(((unsigned)h) << 16); }
__device__ __forceinline__ float siluf(float x) { return x * __builtin_amdgcn_rcpf(1.f + __expf(-x)); }
__device__ __forceinline__ float sigmf(float x) { return __builtin_amdgcn_rcpf(1.f + __expf(-x)); }
__device__ __forceinline__ float softplusf(float x) { return fmaxf(x, 0.f) + log1pf(__expf(-fabsf(x))); }
__device__ __forceinline__ float shx(float v, int o, int lane) {
  return __int_as_float(__builtin_amdgcn_ds_bpermute((lane ^ o) << 2, __float_as_int(v)));
}
__device__ __forceinline__ float shl_(float v, int src) {
  return __int_as_float(__builtin_amdgcn_ds_bpermute(src << 2, __float_as_int(v)));
}
__device__ __forceinline__ float wave_sum(float v, int lane) {
#pragma unroll
  for (int o = 32; o > 0; o >>= 1) v += shx(v, o, lane);
  return v;
}
__device__ __forceinline__ void glds16(const void* g, void* l) {
  __builtin_amdgcn_global_load_lds((const unsigned*)g, (__attribute__((address_space(3))) unsigned*)l, 16, 0, 0);
}
__device__ __forceinline__ int otid() { int t = threadIdx.x; asm volatile("" : "+v"(t)); return t; }
#define LAUNDER(q, p) const Params& q = (p);
__device__ __forceinline__ void wait_vm0() { asm volatile("s_waitcnt vmcnt(0)" ::: "memory"); }


#define XB_TMO      128
#define XB_XCNT(j)  (256  + 64 * (j))
#define XB_XSUB(j)  (1280 + 64 * (j))
#define XB_XGEN(j)  (2304 + 64 * (j))
#define XB_TOP      3328
#define XB_TOPGEN   3392
#define XCD_BAR_WORDS 3456
#define XB_SPIN_CAP (1u << 20)
#define LAS __attribute__((address_space(3)))
__device__ __forceinline__ unsigned xb_ld(unsigned* p)              { return __hip_atomic_load(p, __ATOMIC_RELAXED, __HIP_MEMORY_SCOPE_AGENT); }
__device__ __forceinline__ unsigned xb_add(unsigned* p, unsigned v) { return __hip_atomic_fetch_add(p, v, __ATOMIC_RELAXED, __HIP_MEMORY_SCOPE_AGENT); }
__device__ __forceinline__ unsigned xb_xcc_id() { return (unsigned)__builtin_amdgcn_s_getreg((3 << 11) | 20) & 0xFu; }
#define XB_SPIN(cond, bar) do { unsigned _sp = 0; while (cond) { __builtin_amdgcn_s_sleep(1); \
    if ((++_sp & 255u) == 0u) { if (xb_ld(&(bar)[XB_TMO])) break; if (_sp > XB_SPIN_CAP) { atomicAdd(&(bar)[XB_TMO], 1u); break; } } } } while (0)
struct XcdBarrier { unsigned* bar; unsigned x; volatile LAS unsigned* st; };
__device__ __forceinline__ XcdBarrier xcd_barrier_post(unsigned* bar, volatile LAS unsigned* st) {
  XcdBarrier b; b.bar = bar; b.x = xb_xcc_id(); b.st = st;
  if (threadIdx.x == 0) (void)xb_add(&bar[XB_XCNT(b.x)], 1u);
  return b;
}
__device__ __forceinline__ void xcd_barrier_complete(unsigned* bar, unsigned x, unsigned& nloc, unsigned& nx) {
  const unsigned G = gridDim.x * gridDim.y * gridDim.z;
  unsigned sum, cnt, mine, sp = 0u;
  for (;;) {
    sum = 0u; cnt = 0u; mine = 0u;
#pragma unroll
    for (unsigned j = 0; j < 16; ++j) { const unsigned c = xb_ld(&bar[XB_XCNT(j)]); sum += c; cnt += (c > 0u) ? 1u : 0u; mine = (j == x) ? c : mine; }
    if (sum == G) break;
    __builtin_amdgcn_s_sleep(1);
    if ((++sp & 255u) == 0u) { if (xb_ld(&bar[XB_TMO])) break; if (sp > XB_SPIN_CAP) { atomicAdd(&bar[XB_TMO], 1u); break; } }
  }
  nloc = mine > 0u ? mine : 1u; nx = cnt > 0u ? cnt : 1u;
}
__device__ __forceinline__ void xcd_barrier(const XcdBarrier& b) {
  asm volatile("s_waitcnt vmcnt(0)" ::: "memory");
  __syncthreads();
  if (threadIdx.x == 0) {
    unsigned* bar = b.bar;
    __builtin_amdgcn_s_waitcnt(0);
    unsigned nloc = b.st[0], nx = b.st[1];
    if (nloc == 0u) { xcd_barrier_complete(bar, b.x, nloc, nx); b.st[0] = nloc; b.st[1] = nx; }
    const unsigned old = xb_add(&bar[XB_XSUB(b.x)], 1u);
    const unsigned gen = old / nloc;
    if (old + 1u == (gen + 1u) * nloc) {
      __builtin_amdgcn_fence(__ATOMIC_RELEASE, "agent");
      asm volatile("s_waitcnt vmcnt(0)" ::: "memory");
      const unsigned og = xb_add(&bar[XB_TOP], 1u);
      const unsigned tg = og / nx;
      if (og + 1u == (tg + 1u) * nx) xb_add(&bar[XB_TOPGEN], 1u);
      else XB_SPIN(xb_ld(&bar[XB_TOPGEN]) == tg, bar);
      __builtin_amdgcn_fence(__ATOMIC_ACQUIRE, "agent");
      xb_add(&bar[XB_XGEN(b.x)], 1u);
      asm volatile("s_waitcnt vmcnt(0)" ::: "memory");
    } else {
      XB_SPIN(xb_ld(&bar[XB_XGEN(b.x)]) == gen, bar);
      __builtin_amdgcn_fence(__ATOMIC_ACQUIRE, "agent");
      asm volatile("s_waitcnt vmcnt(0)" ::: "memory");
    }
  }
  __syncthreads();
}

__device__ __forceinline__ int tok_seq(int t) { return t < NTC ? (t >> 8) : 16 + ((t - NTC) >> 12); }
__device__ __forceinline__ int seq_tok0(int s) { return s < 16 ? s * 256 : NTC + (s - 16) * 4096; }
__device__ __forceinline__ int seq_len(int s) { return s < 16 ? 256 : 4096; }
__device__ __forceinline__ int seq_lk(int s) { return s < 16 ? 256 : 4608; }
__device__ __forceinline__ int seq_mv(int s) { return s < 16 ? 0 : s - 15; }
__device__ __forceinline__ size_t krow0(int s, int h) {
  return s < 16 ? (size_t)(s * 4 + h) * 256 : (size_t)16384 + (size_t)((s - 16) * 4 + h) * 4608;
}
__device__ __forceinline__ const float* xrow_ptr(const Params& p, int l, int t) {
  if (l == 0) return t < NTC ? p.in[0] + (size_t)t * DM : p.in[1] + (size_t)(t - NTC) * DM;
  return p.out + (size_t)t * DM;
}
__device__ __forceinline__ int in_src_col(int n) {
  if (n < 2560) return n;
  if (n < 3584) return n + 16;
  if (n < 3600) return n - 3584 + 2560;
  if (n < 3616) return n;
  return -1;
}

__device__ void wconv_tile(const float* W, int K, int N, u16* Wt, int mode, int kt, int nt, char* smem) {
  float* tile = (float*)smem;
  const int tid = otid();
  __syncthreads();
  for (int e = tid; e < 1024; e += 256) {
    int kk = e >> 4, nn = (e & 15) * 4;
    int nd = nt * 64 + nn;
    int src;
    if (mode == 0) src = nd;
    else if (mode == 1) src = in_src_col(nd);
    else {
      int t128 = nd >> 7, w = nd & 127; int pq = w >> 5, half = (w >> 4) & 1, r = w & 15;
      src = half * FF + t128 * 64 + (pq >> 1) * 32 + (r >> 2) * 8 + (pq & 1) * 4 + (r & 3);
    }
    float4 v = make_float4(0.f, 0.f, 0.f, 0.f);
    if (src >= 0) v = *(const float4*)(W + (size_t)(kt * 64 + kk) * N + src);
    float* d = tile + kk * 65 + nn;
    d[0] = v.x; d[1] = v.y; d[2] = v.z; d[3] = v.w;
  }
  __syncthreads();
  for (int e = tid; e < 2048; e += 256) {
    int nn = e >> 5, k2 = (e & 31) * 2;
    unsigned v = pack2(tile[k2 * 65 + nn], tile[(k2 + 1) * 65 + nn]);
    *(unsigned*)(Wt + (size_t)(nt * 64 + nn) * K + kt * 64 + k2) = v;
  }
}

__device__ void wconv_job(const float* W, u16* Wt, int K, int N, int Np, int mode, char* smem, int bid, int nb) {
  int nkt = K / 64, nnt = Np / 64;
  for (int t = bid; t < nkt * nnt; t += nb) wconv_tile(W, K, N, Wt, mode, t / nnt, t % nnt, smem);
}

__device__ void mod_task(const Params& p, int task, char* smem) {
  float* sc = (float*)smem;
  float* red = sc + 5 * 1024;
  const int tid = otid();
  __syncthreads();
  for (int e = tid; e < 5 * 1024; e += 256) {
    int mv = e >> 10, k = e & 1023;
    float c = mv == 0 ? p.in[9][k] : p.in[8][(mv - 1) * 1024 + k];
    sc[e] = siluf(c);
  }
  __syncthreads();
  int l = task / 96, cg0 = (task % 96) * 64;
  int quad = tid & 15, kg = tid >> 4;
  const float* W = p.in[12] + (size_t)l * 1024 * 6144 + cg0 + quad * 4;
  float acc[5][4];
#pragma unroll
  for (int a = 0; a < 5; ++a)
#pragma unroll
    for (int b = 0; b < 4; ++b) acc[a][b] = 0.f;
  for (int kk = 0; kk < 64; ++kk) {
    int k = kg * 64 + kk;
    float4 w = *(const float4*)(W + (size_t)k * 6144);
#pragma unroll
    for (int a = 0; a < 5; ++a) {
      float s = sc[a * 1024 + k];
      acc[a][0] += s * w.x; acc[a][1] += s * w.y; acc[a][2] += s * w.z; acc[a][3] += s * w.w;
    }
  }
#pragma unroll
  for (int a = 0; a < 5; ++a)
#pragma unroll
    for (int b = 0; b < 4; ++b) red[(kg * 5 + a) * 64 + quad * 4 + b] = acc[a][b];
  __syncthreads();
  float* modv = (float*)(p.ws + OFF_MODV);
  for (int e = tid; e < 320; e += 256) {
    int a = e >> 6, c = e & 63;
    float s = p.in[13][l * 6144 + cg0 + c];
    for (int g = 0; g < 16; ++g) s += red[(g * 5 + a) * 64 + c];
    modv[(size_t)(l * 5 + a) * 6144 + cg0 + c] = s;
  }
}

__device__ void misc_task(const Params& p) {
  const int tid = otid();
  float2* rope = (float2*)(p.ws + OFF_ROPE);
  for (int e = tid; e < 1024; e += 256) {
    int pos = e >> 4, f = e & 15;
    float inv = powf(10000.f, -(float)f / 16.f);
    float ang = (float)pos * inv;
    rope[e] = make_float2(cosf(ang), sinf(ang));
  }
  if (tid < 2) {
    const float* lq = p.in[17] + tid * 256;
    float s1 = 0.f, s2 = 0.f;
    for (int i = 0; i < 64; ++i) { s1 += lq[i] * lq[64 + i]; s2 += lq[128 + i] * lq[192 + i]; }
    float lam_init = 0.8f - 0.6f * expf(-0.3f * (float)tid);
    ((float*)(p.ws + OFF_LAM))[tid] = expf(s1) - expf(s2) + lam_init;
  }
  if (tid < 16) ((unsigned*)(p.ws + OFF_CNT))[tid] = 0u;
}

__device__ void norm_phase(const Params& p, int l, int which, int bid, int nb) {
  const int tid_ = otid();
  const int wave = tid_ >> 6, lane = tid_ & 63;
  const float* g = p.in[which == 0 ? 10 : 11] + l * 1024;
  const float* modv = (const float*)(p.ws + OFF_MODV);
  u16* U = (u16*)(p.ws + OFF_U);
  for (int t = bid * 4 + wave; t < NT / 2; t += nb * 4) {
    float4 v[2][4];
    float ss[2] = {0.f, 0.f};
#pragma unroll
    for (int h2 = 0; h2 < 2; ++h2) {
      const float* x = xrow_ptr(p, which == 0 ? l : 1, t + h2 * (NT / 2));
#pragma unroll
      for (int i = 0; i < 4; ++i) {
        v[h2][i] = *(const float4*)(x + i * 256 + lane * 4);
        ss[h2] += v[h2][i].x * v[h2][i].x + v[h2][i].y * v[h2][i].y + v[h2][i].z * v[h2][i].z + v[h2][i].w * v[h2][i].w;
      }
    }
#pragma unroll
    for (int o = 32; o > 0; o >>= 1) { ss[0] += shx(ss[0], o, lane); ss[1] += shx(ss[1], o, lane); }
#pragma unroll
    for (int h2 = 0; h2 < 2; ++h2) {
      const int tt = t + h2 * (NT / 2);
      const int mv = seq_mv(tok_seq(tt));
      const float* sh = modv + (size_t)(l * 5 + mv) * 6144 + (which == 0 ? 0 : 3) * 1024;
      const float* sc = sh + 1024;
      const float rs = rsqrtf(ss[h2] * (1.f / 1024.f) + EPSF);
#pragma unroll
      for (int i = 0; i < 4; ++i) {
        int c = i * 256 + lane * 4;
        float4 gg = *(const float4*)(g + c), s4 = *(const float4*)(sc + c), h4 = *(const float4*)(sh + c);
        float a0 = v[h2][i].x * rs * gg.x * (1.f + s4.x) + h4.x;
        float a1 = v[h2][i].y * rs * gg.y * (1.f + s4.y) + h4.y;
        float a2 = v[h2][i].z * rs * gg.z * (1.f + s4.z) + h4.z;
        float a3 = v[h2][i].w * rs * gg.w * (1.f + s4.w) + h4.w;
        uint2 o; o.x = pack2(a0, a1); o.y = pack2(a2, a3);
        *(uint2*)(U + (size_t)tt * 1024 + c) = o;
      }
    }
  }
}

__device__ void cache_conv(const Params& p, int l, char* smem, int bid, int nb) {
  u16* K = (u16*)(p.ws + OFF_K);
  u16* VT = (u16*)(p.ws + OFF_VT);
  const int tid_ = otid();
  for (int e = bid * 256 + tid_; e < 262144; e += nb * 256) {
    int c4 = (e & 31) * 4, h = (e >> 5) & 3, pt = (e >> 7) & 511, b = e >> 16;
    float4 v = *(const float4*)(p.in[2] + ((size_t)((b * 2 + l) * 512 + pt) * 4 + h) * 128 + c4);
    uint2 o; o.x = pack2(v.x, v.y); o.y = pack2(v.z, v.w);
    *(uint2*)(K + (krow0(16 + b, h) + 4096 + pt) * 128 + c4) = o;
  }
  u16* T = (u16*)smem;
  for (int tile = bid; tile < 128; tile += nb) {
    int pt0 = (tile & 7) * 64, h = (tile >> 3) & 3, b = tile >> 5;
    __syncthreads();
    for (int e = tid_; e < 2048; e += 256) {
      int pt = e >> 5, c4 = (e & 31) * 4;
      float4 v = *(const float4*)(p.in[3] + ((size_t)((b * 2 + l) * 512 + pt0 + pt) * 4 + h) * 128 + c4);
      const int a4 = (pt >> 2) & 3;
      const int pp = (pt & ~15) | ((((a4 & 1) << 1) | (a4 >> 1)) << 2) | (pt & 3);
      T[(c4 + 0) * 72 + pp] = f2bf(v.x); T[(c4 + 1) * 72 + pp] = f2bf(v.y);
      T[(c4 + 2) * 72 + pp] = f2bf(v.z); T[(c4 + 3) * 72 + pp] = f2bf(v.w);
    }
    __syncthreads();
    for (int e = tid_; e < 1024; e += 256) {
      int c = e >> 3, ch = e & 7;
      uint4 v = *(const uint4*)(T + c * 72 + ch * 8);
      *(uint4*)(VT + krow0(16 + b, h) * 128 + (size_t)c * 4608 + 4096 + pt0 + ch * 8) = v;
    }
  }
}

enum { EPI_IN = 0, EPI_RES1 = 1, EPI_SWIGLU = 2, EPI_RES2 = 3 };

template <int EPI>
__device__ __forceinline__ void gemm_epilogue(const Params& p, int l, int rowbase, int nt, f32x4 (&acc)[4][4]) {
  const int tid_ = otid();
  const int lane = tid_ & 63, wave = tid_ >> 6;
  const int wn = wave & 1, r = lane & 15, q = lane >> 4;
  const int m0 = rowbase;
  const int seq = tok_seq(m0);
  const int mv = seq_mv(seq);
  const float* modv = (const float*)(p.ws + OFF_MODV) + (size_t)(l * 5 + mv) * 6144;
  if (EPI == EPI_RES1 || EPI == EPI_RES2) {
    const float* gate = modv + (EPI == EPI_RES1 ? 2 : 5) * 1024;
    float4 x4[4][4], g4[4];
#pragma unroll
    for (int ns = 0; ns < 4; ++ns) g4[ns] = *(const float4*)(gate + nt * 128 + wn * 64 + ns * 16 + 4 * q);
#pragma unroll
    for (int ms = 0; ms < 4; ++ms) {
      const int t = m0 + ms * 16 + r;
      const float* xr = (EPI == EPI_RES1) ? xrow_ptr(p, l, t) : p.out + (size_t)t * DM;
#pragma unroll
      for (int ns = 0; ns < 4; ++ns) x4[ms][ns] = *(const float4*)(xr + nt * 128 + wn * 64 + ns * 16 + 4 * q);
    }
#pragma unroll
    for (int ms = 0; ms < 4; ++ms) {
      const int t = m0 + ms * 16 + r;
      float* xo = p.out + (size_t)t * DM;
#pragma unroll
      for (int ns = 0; ns < 4; ++ns) {
        const int col = nt * 128 + wn * 64 + ns * 16 + 4 * q;
        float4 o;
        o.x = x4[ms][ns].x + g4[ns].x * acc[ms][ns][0]; o.y = x4[ms][ns].y + g4[ns].y * acc[ms][ns][1];
        o.z = x4[ms][ns].z + g4[ns].z * acc[ms][ns][2]; o.w = x4[ms][ns].w + g4[ns].w * acc[ms][ns][3];
        *(float4*)(xo + col) = o;
      }
    }
  } else if (EPI == EPI_SWIGLU) {
    u16* H = (u16*)(p.ws);
#pragma unroll
    for (int ms = 0; ms < 4; ++ms) {
      const int t = m0 + ms * 16 + r;
      float hv[2][4];
#pragma unroll
      for (int pp = 0; pp < 2; ++pp)
#pragma unroll
        for (int i = 0; i < 4; ++i) hv[pp][i] = siluf(acc[ms][2 * pp][i]) * acc[ms][2 * pp + 1][i];
      uint4 o;
      o.x = pack2(hv[0][0], hv[0][1]); o.y = pack2(hv[0][2], hv[0][3]);
      o.z = pack2(hv[1][0], hv[1][1]); o.w = pack2(hv[1][2], hv[1][3]);
      *(uint4*)(H + (size_t)t * FF + nt * 64 + wn * 32 + q * 8) = o;
    }
  } else {
    const bool latent = seq >= 16;
    const int tok0 = seq_tok0(seq);
    const float* bias = p.in[15] + l * INW;
    const float2* rope = (const float2*)(p.ws + OFF_ROPE);
#pragma unroll
    for (int ms = 0; ms < 4; ++ms)
#pragma unroll
      for (int ns = 0; ns < 4; ++ns) {
        int c = wn * 64 + ns * 16 + r;
        int ncol = nt * 128 + c;
        int sc = in_src_col(ncol);
        float bv = sc >= 0 ? bias[sc] : 0.f;
        float v[4];
#pragma unroll
        for (int i = 0; i < 4; ++i) v[i] = acc[ms][ns][i] + bv;
        int tb = m0 + ms * 16 + 4 * q;
        if (nt < 8) {
          int head = nt & 3;
          if (latent) {
            int d = c & 63, pi = d >> 1;
#pragma unroll
            for (int i = 0; i < 4; ++i) {
              float other = __int_as_float(__builtin_amdgcn_mov_dpp(__float_as_int(v[i]), 0xB1, 0xF, 0xF, true));
              int tl = tb + i - tok0;
              int pos = pi < 16 ? (tl >> 6) : (tl & 63);
              float2 cs = rope[pos * 16 + (pi & 15)];
              v[i] = (d & 1) ? (other * cs.y + v[i] * cs.x) : (v[i] * cs.x - other * cs.y);
            }
          }
          if (nt < 4) {
            u16* Q = (u16*)(p.ws + OFF_Q);
#pragma unroll
            for (int i = 0; i < 4; ++i) Q[(size_t)(tb + i) * 512 + head * 128 + c] = f2bf(v[i] * (0.125f * LOG2E));
          } else {
            u16* K = (u16*)(p.ws + OFF_K);
            size_t kr = krow0(seq, head) + (tb - tok0);
#pragma unroll
            for (int i = 0; i < 4; ++i) K[(kr + i) * 128 + c] = f2bf(v[i]);
            if (!latent) {
#pragma unroll
              for (int i = 0; i < 4; ++i)
                p.out[OUT_NK + ((size_t)((seq * 2 + l) * 256 + (tb + i - tok0)) * 4 + head) * 128 + c] = v[i];
            }
          }
        } else if (nt < 12) {
          int head = nt - 8;
          u16* VT = (u16*)(p.ws + OFF_VT);
          uint2 o; o.x = pack2(v[0], v[1]); o.y = pack2(v[2], v[3]);
          const int tl0 = tb - tok0;
          const int a4 = (tl0 >> 2) & 3;
          const int tperm = (tl0 & ~15) | ((((a4 & 1) << 1) | (a4 >> 1)) << 2);
          *(uint2*)(VT + krow0(seq, head) * 128 + (size_t)c * seq_lk(seq) + tperm) = o;
          if (!latent) {
#pragma unroll
            for (int i = 0; i < 4; ++i)
              p.out[OUT_NV + ((size_t)((seq * 2 + l) * 256 + (tb + i - tok0)) * 4 + head) * 128 + c] = v[i];
          }
        } else if (nt < 18) {
          u16* B = (u16*)(p.ws + OFF_BPRE);
#pragma unroll
          for (int i = 0; i < 4; ++i) B[(size_t)(tb + i) * 768 + (nt - 12) * 128 + c] = f2bf(v[i]);
        } else if (nt < 20) {
          u16* B = (u16*)(p.ws + OFF_BG);
#pragma unroll
          for (int i = 0; i < 4; ++i) B[(size_t)(tb + i) * 256 + (nt - 18) * 128 + c] = f2bf(v[i]);
        } else if (nt < 26) {
          u16* B = (u16*)(p.ws + OFF_CQKV);
          float s = (nt == 22 || nt == 23) ? 0.125f : 1.f;
#pragma unroll
          for (int i = 0; i < 4; ++i) B[(size_t)(tb + i) * 768 + (nt - 20) * 128 + c] = f2bf(v[i] * s);
        } else if (nt < 28) {
          u16* B = (u16*)(p.ws + OFF_CO);
#pragma unroll
          for (int i = 0; i < 4; ++i) B[(size_t)(tb + i) * 256 + (nt - 26) * 128 + c] = f2bf(v[i]);
        } else {
          if (c < 32) {
            float* G = (float*)(p.ws + OFF_GATE);
#pragma unroll
            for (int i = 0; i < 4; ++i) G[(size_t)(tb + i) * 32 + c] = v[i];
          }
        }
      }
  }
}

template <int EPI>
__device__ void gemm_tile(const Params& p, int l, const u16* A0, int lda0, const u16* A1, int lda1, int ksplit,
                          const u16* Bt, int K, int mt, int nt, char* smem) {
  const int tid = otid(), lane = tid & 63, wave = tid >> 6;
  const int wm = wave >> 1, wn = wave & 1, r = lane & 15, q = lane >> 4;
  const int nk = K / 64;
  f32x4 acc[4][4];
#pragma unroll
  for (int a = 0; a < 4; ++a)
#pragma unroll
    for (int b = 0; b < 4; ++b) acc[a][b] = (f32x4){0.f, 0.f, 0.f, 0.f};

  const int srow = wave * 8 + (lane >> 3);
  const unsigned kcb = (unsigned)(((lane & 7) ^ ((srow >> 1) & 7)) * 16);
  const unsigned ldst0 = (unsigned)(wave * 1024 + lane * 16);
  auto issue = [&](int kt, int buf) {
    char* sA = smem + buf * 32768 + ldst0;
    char* sB = sA + 16384;
    const int k0 = kt * 64;
    const char* Ab; unsigned lda2; unsigned ka;
    if (k0 < ksplit) { Ab = (const char*)(A0 + (size_t)mt * 128 * lda0); lda2 = (unsigned)lda0 * 2; ka = (unsigned)k0 * 2; }
    else { Ab = (const char*)(A1 + (size_t)mt * 128 * lda1); lda2 = (unsigned)lda1 * 2; ka = (unsigned)(k0 - ksplit) * 2; }
    const char* Bb = (const char*)(Bt + (size_t)nt * 128 * K);
    const unsigned ao = (unsigned)srow * lda2 + kcb + ka, bo = (unsigned)srow * (unsigned)(K * 2) + kcb + (unsigned)k0 * 2;
#pragma unroll
    for (int i = 0; i < 4; ++i) {
      glds16(Ab + (ao + (unsigned)i * 32u * lda2), sA + i * 4096);
      glds16(Bb + (bo + (unsigned)i * 32u * (unsigned)(K * 2)), sB + i * 4096);
    }
  };
  __syncthreads();
  issue(0, 0);
  for (int kt = 0; kt < nk; ++kt) {
    wait_vm0();
    __syncthreads();
    if (kt + 1 < nk) issue(kt + 1, (kt + 1) & 1);
    const char* sA = smem + (kt & 1) * 32768;
    const char* sB = sA + 16384;
    __builtin_amdgcn_iglp_opt(0);
#pragma unroll
    for (int s = 0; s < 2; ++s) {
      bf16x8 af[4], bfr[4];
#pragma unroll
      for (int ms = 0; ms < 4; ++ms) {
        int row = wm * 64 + ms * 16 + r;
        af[ms] = *(const bf16x8*)(sA + row * 128 + (((s * 4 + q) ^ ((row >> 1) & 7)) * 16));
      }
#pragma unroll
      for (int ns = 0; ns < 4; ++ns) {
        int row = wn * 64 + ns * 16 + r;
        bfr[ns] = *(const bf16x8*)(sB + row * 128 + (((s * 4 + q) ^ ((row >> 1) & 7)) * 16));
      }
#pragma unroll
      for (int ms = 0; ms < 4; ++ms)
#pragma unroll
        for (int ns = 0; ns < 4; ++ns)
          acc[ms][ns] = (EPI == EPI_IN) ? MFMA16(af[ms], bfr[ns], acc[ms][ns]) : MFMA16(bfr[ns], af[ms], acc[ms][ns]);
    }
  }
  gemm_epilogue<EPI>(p, l, mt * 128 + wm * 64, nt, acc);
}


__device__ __forceinline__ bool tile_map(int bid, int nb, int it, int ntm, int ntn, int& m, int& n) {
  if (nb != 512 || (ntm & 7)) {
    int t = bid + it * nb;
    if (t >= ntm * ntn) return false;
    m = t % ntm; n = t / ntm;
    return true;
  }
  const int x = bid & 7, j = bid >> 3, MX = ntm >> 3;
  int u = it * 64 + j;
  const int fullp = ntn >> 3;
  int np, wp;
  if (u < fullp * 8 * MX) { np = u / (8 * MX); u -= np * 8 * MX; wp = 8; }
  else { np = fullp; u -= fullp * 8 * MX; wp = ntn & 7; if (u >= wp * MX) return false; }
  m = x * MX + u / wp;
  n = np * 8 + u % wp;
  return true;
}

template <int EPI>
__device__ void gemm_phase(const Params& p, int l, const u16* A0, int lda0, const u16* A1, int lda1, int ksplit,
                           const u16* Bt, int K, int ntn, char* smem, int bid, int nb) {
  const int ntm = NT / 128;
  int m, n;
  for (int it = 0; tile_map(bid, nb, it, ntm, ntn, m, n); ++it) gemm_tile<EPI>(p, l, A0, lda0, A1, lda1, ksplit, Bt, K, m, n, smem);
}


template <int EPI>
__device__ void gemm_tile_big(const Params& p, int l, const u16* A, int lda, const u16* Bt, int K, int mt, int nt, char* smem) {
  const int tid = otid(), lane = tid & 63, wave = tid >> 6;
  const int wm = wave >> 1, wn = wave & 1, r = lane & 15, q = lane >> 4;
  const int nk = K / 32;
  f32x4 acc[2][4][4];
#pragma unroll
  for (int hf = 0; hf < 2; ++hf)
#pragma unroll
    for (int a = 0; a < 4; ++a)
#pragma unroll
      for (int b = 0; b < 4; ++b) acc[hf][a][b] = (f32x4){0.f, 0.f, 0.f, 0.f};
  const int srow = wave * 16 + (lane >> 2);
  const unsigned kcb = (unsigned)(((lane & 3) ^ ((srow >> 2) & 3)) * 16);
  const unsigned ldst0 = (unsigned)(wave * 1024 + lane * 16);
  const char* Ab = (const char*)(A + (size_t)mt * 256 * lda);
  const char* Bb = (const char*)(Bt + (size_t)nt * 128 * K);
  const unsigned lda2 = (unsigned)lda * 2, ldb2 = (unsigned)K * 2;
  auto issue = [&](int kt, int buf) {
    char* sA = smem + buf * 24576 + ldst0;
    char* sB = sA + 16384;
    const unsigned ao = (unsigned)srow * lda2 + kcb + (unsigned)kt * 64u, bo = (unsigned)srow * ldb2 + kcb + (unsigned)kt * 64u;
#pragma unroll
    for (int i = 0; i < 4; ++i) glds16(Ab + (ao + (unsigned)i * 64u * lda2), sA + i * 4096);
#pragma unroll
    for (int i = 0; i < 2; ++i) glds16(Bb + (bo + (unsigned)i * 64u * ldb2), sB + i * 4096);
  };
  __syncthreads();
  issue(0, 0);
  issue(1, 1);
  int stg = 0;
  for (int kt = 0; kt < nk; ++kt) {
    if (kt + 1 < nk) asm volatile("s_waitcnt vmcnt(6)" ::: "memory");
    else asm volatile("s_waitcnt vmcnt(0)" ::: "memory");
    __builtin_amdgcn_s_barrier();
    if (kt + 2 < nk) issue(kt + 2, stg >= 1 ? stg - 1 : 2);
    const unsigned bo = (unsigned)stg * 24576u;
    stg = stg == 2 ? 0 : stg + 1;
    __builtin_amdgcn_iglp_opt(0);
    bf16x8 bfr[4];
#pragma unroll
    for (int ns = 0; ns < 4; ++ns) {
      int row = wn * 64 + ns * 16 + r;
      bfr[ns] = *(const bf16x8*)(smem + bo + 16384u + (unsigned)row * 64u + (unsigned)((q ^ ((row >> 2) & 3)) * 16));
    }
#pragma unroll
    for (int hf = 0; hf < 2; ++hf) {
      bf16x8 af[4];
#pragma unroll
      for (int ms = 0; ms < 4; ++ms) {
        int row = wm * 128 + hf * 64 + ms * 16 + r;
        af[ms] = *(const bf16x8*)(smem + bo + (unsigned)row * 64u + (unsigned)((q ^ ((row >> 2) & 3)) * 16));
      }
#pragma unroll
      for (int ms = 0; ms < 4; ++ms)
#pragma unroll
        for (int ns = 0; ns < 4; ++ns) acc[hf][ms][ns] = MFMA16(bfr[ns], af[ms], acc[hf][ms][ns]);
    }
  }
  gemm_epilogue<EPI>(p, l, mt * 256 + wm * 128, nt, acc[0]);
  gemm_epilogue<EPI>(p, l, mt * 256 + wm * 128 + 64, nt, acc[1]);
}

template <int EPI>
__device__ void gemm_phase_big(const Params& p, int l, const u16* A, int lda, const u16* Bt, int K, int ntn, char* smem, int bid, int nb) {
  const int ntm = NT / 256;
  int m, n;
  for (int it = 0; tile_map(bid, nb, it, ntm, ntn, m, n); ++it) gemm_tile_big<EPI>(p, l, A, lda, Bt, K, m, n, smem);
}

__device__ void prep_item(const Params& p, int l, int ci, int h, char* smem) {
  const int tid = otid(), lane = tid & 63, wave = tid >> 6;
  float* qs = (float*)smem;
  float* ks = qs + 64 * 65;
  float* As = (float*)smem;
  float* gcs = (float*)(smem + 33280);
  float* bes = gcs + 128;
  const int t0 = ci * 64;
  const int seq = tok_seq(t0);
  const int stok0 = seq_tok0(seq), slen = seq_len(seq);
  const int ti = tid >> 4, tj = tid & 15;
  const int item = ci * 4 + h;
  __syncthreads();
  {
    const u16* C = (const u16*)(p.ws + OFF_CQKV);
    for (int e = tid; e < 1024; e += 256) {
      int t = (e >> 3) & 63, ch = e & 7, isk = e >> 9;
      uint4 v = *(const uint4*)(C + (size_t)(t0 + t) * 768 + isk * 256 + h * 64 + ch * 8);
      float* dst = (isk ? ks : qs) + t * 65 + ch * 8;
      dst[0] = bf2f(v.x & 0xffff); dst[1] = bf2f(v.x >> 16); dst[2] = bf2f(v.y & 0xffff); dst[3] = bf2f(v.y >> 16);
      dst[4] = bf2f(v.z & 0xffff); dst[5] = bf2f(v.z >> 16); dst[6] = bf2f(v.w & 0xffff); dst[7] = bf2f(v.w >> 16);
    }
    if (wave < 2) {
      const int dir = wave, i = lane;
      const int t = t0 + (dir ? 63 - i : i);
      const float* G = (const float*)(p.ws + OFF_GATE) + (size_t)t * 32 + dir * 4 + h;
      float ba = G[0], bb = G[8], ig = G[16], cf = G[24] + p.in[23][l * 8 + dir * 4 + h];
      float lf = fminf(cf, 0.f) - log1pf(__expf(-fabsf(cf)));
      float g = -__expf(p.in[20][l * 8 + dir * 4 + h]) * softplusf(ba + p.in[21][l * 8 + dir * 4 + h]);
      float be = sigmf(bb);
      float b = lf, gc = g;
#pragma unroll
      for (int o = 1; o < 64; o <<= 1) {
        float tb = shl_(b, (lane - o) & 63), tg = shl_(gc, (lane - o) & 63);
        if (lane >= o) { b += tb; gc += tg; }
      }
      float a = ig - b, pm = a;
#pragma unroll
      for (int o = 1; o < 64; o <<= 1) {
        float tp = shl_(pm, (lane - o) & 63);
        if (lane >= o) pm = fmaxf(pm, tp);
      }
      float* maux = (float*)(p.ws + OFF_MAUX) + (size_t)(item * 2 + dir) * 192;
      maux[i] = b; maux[64 + i] = a; maux[128 + i] = pm;
      float* daux = (float*)(p.ws + OFF_DAUX) + (size_t)(item * 2 + dir) * 128;
      daux[i] = gc; daux[64 + i] = be;
      gcs[dir * 64 + i] = gc; bes[dir * 64 + i] = be;
    }
    __syncthreads();
    float acc[4][4];
#pragma unroll
    for (int a = 0; a < 4; ++a)
#pragma unroll
      for (int b = 0; b < 4; ++b) acc[a][b] = 0.f;
    for (int d = 0; d < 64; ++d) {
      float x[4], y[4];
#pragma unroll
      for (int a = 0; a < 4; ++a) { x[a] = qs[(4 * ti + a) * 65 + d]; y[a] = ks[(4 * tj + a) * 65 + d]; }
#pragma unroll
      for (int a = 0; a < 4; ++a)
#pragma unroll
        for (int b = 0; b < 4; ++b) acc[a][b] += x[a] * y[b];
    }
    u16* MQK = (u16*)(p.ws + OFF_MQK) + (size_t)item * 4096;
#pragma unroll
    for (int a = 0; a < 4; ++a) {
      uint2 o; o.x = pack2(acc[a][0], acc[a][1]); o.y = pack2(acc[a][2], acc[a][3]);
      *(uint2*)(MQK + (4 * ti + a) * 64 + 4 * tj) = o;
    }
    __syncthreads();
  }
  {
    const u16* B = (const u16*)(p.ws + OFF_BPRE);
    const float* cw = p.in[19] + l * 5 * 768;
    u16* DQ = (u16*)(p.ws + OFF_DQKV) + (size_t)item * 3 * 4096;
    float* xs = (float*)(smem + 34304);
#pragma unroll 1
    for (int part = 0; part < 3; ++part) {
      int ch = part * 256 + h * 64 + lane;
      float w0 = cw[ch], w1 = cw[768 + ch], w2 = cw[2 * 768 + ch], w3 = cw[3 * 768 + ch], w4 = cw[4 * 768 + ch];
      __syncthreads();
      for (int e = tid; e < 544; e += 256) {
        int rr = e >> 3, c8 = e & 7;
        int tl = (t0 - stok0) + rr - 2;
        uint4 v = make_uint4(0u, 0u, 0u, 0u);
        if (tl >= 0 && tl < slen) v = *(const uint4*)(B + (size_t)(stok0 + tl) * 768 + part * 256 + h * 64 + c8 * 8);
        float* dst = xs + rr * 64 + c8 * 8;
        dst[0] = bf2f(v.x & 0xffff); dst[1] = bf2f(v.x >> 16); dst[2] = bf2f(v.y & 0xffff); dst[3] = bf2f(v.y >> 16);
        dst[4] = bf2f(v.z & 0xffff); dst[5] = bf2f(v.z >> 16); dst[6] = bf2f(v.w & 0xffff); dst[7] = bf2f(v.w >> 16);
      }
      __syncthreads();
#pragma unroll 4
      for (int i = 0; i < 16; ++i) {
        int t = wave + 4 * i;
        const float* xr = xs + t * 64 + lane;
        float v = siluf(w0 * xr[0] + w1 * xr[64] + w2 * xr[128] + w3 * xr[192] + w4 * xr[256]);
        if (part < 2) {
          float ss = wave_sum(v * v, lane);
          v *= rsqrtf(ss + EPSF);
          if (part == 0) { v *= 0.125f; qs[t * 65 + lane] = v; } else ks[t * 65 + lane] = v;
        }
        DQ[part * 4096 + t * 64 + lane] = f2bf(v);
      }
    }
    __syncthreads();
  }
  float gk[4][4], qk[4][4];
#pragma unroll
  for (int a = 0; a < 4; ++a)
#pragma unroll
    for (int b = 0; b < 4; ++b) { gk[a][b] = 0.f; qk[a][b] = 0.f; }
  for (int d = 0; d < 64; ++d) {
    float x[4], y[4], z[4];
#pragma unroll
    for (int a = 0; a < 4; ++a) { x[a] = qs[(4 * ti + a) * 65 + d]; z[a] = ks[(4 * ti + a) * 65 + d]; y[a] = ks[(4 * tj + a) * 65 + d]; }
#pragma unroll
    for (int a = 0; a < 4; ++a)
#pragma unroll
      for (int b = 0; b < 4; ++b) { qk[a][b] += x[a] * y[b]; gk[a][b] += z[a] * y[b]; }
  }
  __syncthreads();
  u16* PR1 = (u16*)(p.ws + OFF_U);
#pragma unroll
  for (int dir = 0; dir < 2; ++dir) {
    u16* AQ = PR1 + ((size_t)(item * 2 + dir) * 2 + 1) * 4096;
#pragma unroll
    for (int a = 0; a < 4; ++a) {
      int ir = 4 * ti + a;
      int ip = dir ? 63 - ir : ir;
      float gi = gcs[dir * 64 + ip], bi = bes[dir * 64 + ip];
#pragma unroll
      for (int b = 0; b < 4; ++b) {
        int jr = 4 * tj + b;
        int jp = dir ? 63 - jr : jr;
        float e = __expf(gi - gcs[dir * 64 + jp]);
        float akk = (jp < ip) ? bi * gk[a][b] * e : 0.f;
        float aqk = (jp <= ip) ? qk[a][b] * e : 0.f;
        As[(dir * 64 + ip) * 64 + jp] = akk;
        AQ[ip * 64 + jp] = f2bf(aqk);
      }
    }
  }
  __syncthreads();
  if (wave < 2) {
    const float* A = As + wave * 4096;
    u16* T = PR1 + ((size_t)(item * 2 + wave) * 2 + 0) * 4096;
    float tc[64];
#pragma unroll
    for (int i = 0; i < 64; ++i) {
      float acc = (i == lane) ? 1.f : 0.f;
#pragma unroll
      for (int j4 = 0; j4 < (i + 3) / 4; ++j4) {
        float4 a = *(const float4*)(A + i * 64 + j4 * 4);
        if (j4 * 4 + 0 < i) acc -= a.x * tc[j4 * 4 + 0];
        if (j4 * 4 + 1 < i) acc -= a.y * tc[j4 * 4 + 1];
        if (j4 * 4 + 2 < i) acc -= a.z * tc[j4 * 4 + 2];
        if (j4 * 4 + 3 < i) acc -= a.w * tc[j4 * 4 + 3];
      }
      tc[i] = acc;
      T[i * 64 + lane] = f2bf(acc);
    }
  }
}

constexpr int SROW = 136;
constexpr int SIMG = 64 * SROW;

__device__ __forceinline__ bf16x8 frag_perm(const char* img, int row, int s, int q) {
  const char* b = img + row * SROW + s * 64 + q * 8;
  s16x4 lo = *(const s16x4*)(b), hi = *(const s16x4*)(b + 32);
  return (bf16x8){lo[0], lo[1], lo[2], lo[3], hi[0], hi[1], hi[2], hi[3]};
}
__device__ __forceinline__ bf16x8 frag_nat(const char* img, int row, int s, int q) {
  const char* b = img + row * SROW + s * 64 + q * 16;
  s16x4 lo = *(const s16x4*)(b), hi = *(const s16x4*)(b + 8);
  return (bf16x8){lo[0], lo[1], lo[2], lo[3], hi[0], hi[1], hi[2], hi[3]};
}
typedef __attribute__((ext_vector_type(4))) unsigned u32x4_t;
__device__ __forceinline__ bf16x8 acc_frag(const f32x4& x0, const f32x4& x1) {
  u32x4_t w = {pack2(x0[0], x0[1]), pack2(x0[2], x0[3]), pack2(x1[0], x1[1]), pack2(x1[2], x1[3])};
  return __builtin_bit_cast(bf16x8, w);
}
__device__ __forceinline__ uint4 img_ld(const u16* g, int gstride, int tid, int i) {
  int e = tid + 256 * i;
  return *(const uint4*)(g + (size_t)(e >> 3) * gstride + (e & 7) * 8);
}
__device__ __forceinline__ void img_st(char* img, uint4 v, int tid, int i, bool rev_rows, bool rev_cols) {
  int e = tid + 256 * i;
  int row = e >> 3, ch = e & 7;
  int drow = rev_rows ? 63 - row : row;
  if (rev_cols) {
    uint4 w;
    w.x = (v.w >> 16) | (v.w << 16); w.y = (v.z >> 16) | (v.z << 16);
    w.z = (v.y >> 16) | (v.y << 16); w.w = (v.x >> 16) | (v.x << 16);
    v = w; ch = 7 - ch;
  }
  char* d = img + drow * SROW + ch * 16;
  *(uint2*)d = make_uint2(v.x, v.y);
  *(uint2*)(d + 8) = make_uint2(v.z, v.w);
}
__device__ __forceinline__ uint4 imgt_ld(const u16* g, int gstride, int tid, int i) {
  int e = tid + 256 * i;
  return *(const uint4*)(g + (size_t)(e & 63) * gstride + (e >> 6) * 8);
}
__device__ __forceinline__ void imgt_st(char* img, uint4 v, int tid, int i, bool rev_rows) {
  int e = tid + 256 * i;
  int row = e & 63, ch = e >> 6;
  int ip = rev_rows ? 63 - row : row;
  unsigned w[4] = {v.x, v.y, v.z, v.w};
#pragma unroll
  for (int j = 0; j < 4; ++j) {
    *(u16*)(img + (ch * 8 + 2 * j) * SROW + ip * 2) = (u16)(w[j] & 0xffffu);
    *(u16*)(img + (ch * 8 + 2 * j + 1) * SROW + ip * 2) = (u16)(w[j] >> 16);
  }
}

__device__ void delta_scan(const Params& p, int l, int seq, int h, int dir, char* smem) {
  const int tid = otid(), lane = tid & 63, wave = tid >> 6;
  const int r = lane & 15, q = lane >> 4;
  char* iK = smem;
  char* iKT = smem + SIMG;
  char* iQ = smem + 2 * SIMG;
  char* iT = smem + 3 * SIMG;
  char* iA = smem + 4 * SIMG;
  char* iV = smem + 5 * SIMG;
  float* sgc = (float*)(smem + 6 * SIMG);
  float* sbe = sgc + 64;
  float* seg = sgc + 128;
  float* skd = sgc + 192;
  const int nch = seq_len(seq) / 64;
  const int ci0 = seq_tok0(seq) / 64;
  const int dvc = wave * 16 + r;
  f32x4 S[4];
  if (seq >= 16) {
    const float* s0 = p.in[4] + ((size_t)(((seq - 16) * 2 + l) * 2 + dir) * 4 + h) * 4096;
#pragma unroll
    for (int t = 0; t < 4; ++t)
#pragma unroll
      for (int i = 0; i < 4; ++i) S[t][i] = s0[(16 * t + 4 * q + i) * 64 + dvc];
  } else {
#pragma unroll
    for (int t = 0; t < 4; ++t) S[t] = (f32x4){0.f, 0.f, 0.f, 0.f};
  }
  u16* O = (u16*)(p.ws + OFF_BPRE) + (size_t)dir * NT * 256;
  uint4 pre[12];
  float preaux = 0.f;
  auto load_chunk = [&](int n) {
    const int cix = ci0 + (dir ? nch - 1 - n : n);
    const int itm = cix * 4 + h;
    const u16* DQ = (const u16*)(p.ws + OFF_DQKV) + (size_t)itm * 3 * 4096;
    const u16* PR = (const u16*)(p.ws + OFF_U) + (size_t)(itm * 2 + dir) * 2 * 4096;
    const float* aux = (const float*)(p.ws + OFF_DAUX) + (size_t)(itm * 2 + dir) * 128;
#pragma unroll
    for (int i = 0; i < 2; ++i) {
      pre[i] = img_ld(DQ, 64, tid, i);
      pre[2 + i] = img_ld(DQ + 4096, 64, tid, i);
      pre[4 + i] = imgt_ld(DQ + 4096, 64, tid, i);
      pre[6 + i] = imgt_ld(DQ + 8192, 64, tid, i);
      pre[8 + i] = img_ld(PR, 64, tid, i);
      pre[10 + i] = img_ld(PR + 4096, 64, tid, i);
    }
    if (tid < 128) preaux = aux[tid];
  };
  load_chunk(0);
  for (int n = 0; n < nch; ++n) {
    const int ci = ci0 + (dir ? nch - 1 - n : n);
    __syncthreads();
#pragma unroll
    for (int i = 0; i < 2; ++i) {
      img_st(iQ, pre[i], tid, i, dir, false);
      img_st(iK, pre[2 + i], tid, i, dir, false);
      imgt_st(iKT, pre[4 + i], tid, i, dir);
      imgt_st(iV, pre[6 + i], tid, i, dir);
      img_st(iT, pre[8 + i], tid, i, false, false);
      img_st(iA, pre[10 + i], tid, i, false, false);
    }
    if (tid < 128) sgc[tid] = preaux;
    if (tid < 64) {
      float glast = __int_as_float(__builtin_amdgcn_readlane(__float_as_int(preaux), 63));
      seg[tid] = __expf(preaux);
      skd[tid] = __expf(glast - preaux);
    }
    __syncthreads();
    if (n + 1 < nch) load_chunk(n + 1);
    const float gl = sgc[63];
    bf16x8 fK[4][2], fQ[4][2], fT[4][2];
    float4 eg4[4], be4[4], kd4[4];
    float vv[4][4];
#pragma unroll
    for (int m = 0; m < 4; ++m) {
      const int row = 16 * m + r;
      fK[m][0] = frag_perm(iK, row, 0, q); fK[m][1] = frag_perm(iK, row, 1, q);
      fQ[m][0] = frag_perm(iQ, row, 0, q); fQ[m][1] = frag_perm(iQ, row, 1, q);
      fT[m][0] = frag_perm(iT, row, 0, q); fT[m][1] = frag_perm(iT, row, 1, q);
      eg4[m] = *(const float4*)(seg + 16 * m + 4 * q);
      be4[m] = *(const float4*)(sbe + 16 * m + 4 * q);
      kd4[m] = *(const float4*)(skd + 16 * m + 4 * q);
      const s16x4 v4 = *(const s16x4*)(iV + dvc * SROW + (16 * m + 4 * q) * 2);
#pragma unroll
      for (int i = 0; i < 4; ++i) vv[m][i] = bf2f((u16)v4[i]);
    }
    bf16x8 sb0 = acc_frag(S[0], S[1]), sb1 = acc_frag(S[2], S[3]);
    f32x4 rr[4], qs_[4];
#pragma unroll
    for (int m = 0; m < 4; ++m) {
      f32x4 m1 = (f32x4){0.f, 0.f, 0.f, 0.f}, qq = m1;
      m1 = MFMA16(fK[m][0], sb0, m1); m1 = MFMA16(fK[m][1], sb1, m1);
      qq = MFMA16(fQ[m][0], sb0, qq); qq = MFMA16(fQ[m][1], sb1, qq);
      const float eg[4] = {eg4[m].x, eg4[m].y, eg4[m].z, eg4[m].w}, be[4] = {be4[m].x, be4[m].y, be4[m].z, be4[m].w};
#pragma unroll
      for (int i = 0; i < 4; ++i) {
        rr[m][i] = be[i] * (vv[m][i] - eg[i] * m1[i]);
        qs_[m][i] = eg[i] * qq[i];
      }
    }
    bf16x8 fA[4][2], fKT[4][2];
#pragma unroll
    for (int m = 0; m < 4; ++m) {
      const int row = 16 * m + r;
      fA[m][0] = frag_perm(iA, row, 0, q); fA[m][1] = frag_perm(iA, row, 1, q);
      fKT[m][0] = frag_perm(iKT, row, 0, q); fKT[m][1] = frag_perm(iKT, row, 1, q);
    }
    bf16x8 rb0 = acc_frag(rr[0], rr[1]), rb1 = acc_frag(rr[2], rr[3]);
    f32x4 vn[4];
#pragma unroll
    for (int m = 0; m < 4; ++m) {
      f32x4 a = (f32x4){0.f, 0.f, 0.f, 0.f};
      a = MFMA16(fT[m][0], rb0, a); a = MFMA16(fT[m][1], rb1, a);
      vn[m] = a;
    }
    bf16x8 vb0 = acc_frag(vn[0], vn[1]), vb1 = acc_frag(vn[2], vn[3]);
#pragma unroll
    for (int m = 0; m < 4; ++m) {
      f32x4 o = qs_[m];
      o = MFMA16(fA[m][0], vb0, o); o = MFMA16(fA[m][1], vb1, o);
      const float kd[4] = {kd4[m].x, kd4[m].y, kd4[m].z, kd4[m].w};
#pragma unroll
      for (int i = 0; i < 4; ++i) {
        int tr = 16 * m + 4 * q + i;
        int tg = ci * 64 + (dir ? 63 - tr : tr);
        O[(size_t)tg * 256 + h * 64 + dvc] = f2bf(o[i]);
        vn[m][i] *= kd[i];
      }
    }
    bf16x8 vd0 = acc_frag(vn[0], vn[1]), vd1 = acc_frag(vn[2], vn[3]);
    const float egl = __expf(gl);
#pragma unroll
    for (int t = 0; t < 4; ++t) {
      f32x4 a = S[t] * egl;
      a = MFMA16(fKT[t][0], vd0, a); a = MFMA16(fKT[t][1], vd1, a);
      S[t] = a;
    }
  }
  if (seq < 16) {
    float* o = p.out + OUT_DS + ((size_t)((seq * 2 + l) * 2 + dir) * 4 + h) * 4096;
#pragma unroll
    for (int t = 0; t < 4; ++t)
#pragma unroll
      for (int i = 0; i < 4; ++i) o[(16 * t + 4 * q + i) * 64 + dvc] = S[t][i];
  }
}

__device__ void mlstm_scan(const Params& p, int l, int seq, int h, int dir, char* smem) {
  const int tid = otid(), lane = tid & 63, wave = tid >> 6;
  const int r = lane & 15, q = lane >> 4;
  char* iQ = smem;
  char* iQK = smem + SIMG;
  char* iKT = smem + 2 * SIMG;
  char* iVT = smem + 3 * SIMG;
  float* sb = (float*)(smem + 4 * SIMG);
  float* sa = sb + 64;
  float* spm = sb + 128;
  float* sea = sb + 192;
  float* rw = sb + 256 + (otid() >> 6) * 256;
  const int nch = seq_len(seq) / 64;
  const int ci0 = seq_tok0(seq) / 64;
  const int dvc = wave * 16 + r;
  f32x4 C[4], N[4];
  float ms;
  if (seq >= 16) {
    size_t sidx = (size_t)(((seq - 16) * 2 + l) * 2 + dir) * 4 + h;
    const float* c0 = p.in[5] + sidx * 4096;
    const float* n0 = p.in[6] + sidx * 64;
    ms = p.in[7][sidx];
#pragma unroll
    for (int t = 0; t < 4; ++t)
#pragma unroll
      for (int i = 0; i < 4; ++i) {
        C[t][i] = c0[(16 * t + 4 * q + i) * 64 + dvc];
        N[t][i] = (r == 0) ? n0[16 * t + 4 * q + i] : 0.f;
      }
  } else {
    ms = 0.f;
#pragma unroll
    for (int t = 0; t < 4; ++t) { C[t] = (f32x4){0.f, 0.f, 0.f, 0.f}; N[t] = C[t]; }
  }
  const short one_bf = (r == 0) ? (short)0x3f80 : (short)0;
  const bf16x8 ones = (bf16x8){one_bf, one_bf, one_bf, one_bf, one_bf, one_bf, one_bf, one_bf};
  u16* O = (u16*)(p.ws + OFF_MOM) + (size_t)dir * NT * 256;
  const u16* CQ = (const u16*)(p.ws + OFF_CQKV);
  uint4 pre[8];
  float preaux = 0.f;
  auto load_chunk = [&](int n) {
    const int cix = ci0 + (dir ? nch - 1 - n : n);
    const int itm = cix * 4 + h;
    const float* aux = (const float*)(p.ws + OFF_MAUX) + (size_t)(itm * 2 + dir) * 192;
    const u16* cq = CQ + (size_t)cix * 64 * 768 + h * 64;
#pragma unroll
    for (int i = 0; i < 2; ++i) {
      pre[i] = img_ld(cq, 768, tid, i);
      pre[2 + i] = img_ld((const u16*)(p.ws + OFF_MQK) + (size_t)itm * 4096, 64, tid, i);
      pre[4 + i] = imgt_ld(cq + 256, 768, tid, i);
      pre[6 + i] = imgt_ld(cq + 512, 768, tid, i);
    }
    if (tid < 192) preaux = aux[tid];
  };
  load_chunk(0);
  for (int n = 0; n < nch; ++n) {
    const int ci = ci0 + (dir ? nch - 1 - n : n);
    __syncthreads();
#pragma unroll
    for (int i = 0; i < 2; ++i) {
      img_st(iQ, pre[i], tid, i, dir, false);
      img_st(iQK, pre[2 + i], tid, i, dir, dir);
      imgt_st(iKT, pre[4 + i], tid, i, dir);
      imgt_st(iVT, pre[6 + i], tid, i, dir);
    }
    if (tid < 192) sb[tid] = preaux;
    if (tid >= 64 && tid < 128) sea[tid - 64] = __expf(preaux);
    __syncthreads();
    if (n + 1 < nch) load_chunk(n + 1);
    const float blast = sb[63], pmlast = spm[63];
    {
      float brow = sb[lane];
      float mtl = fmaxf(brow + ms, brow + spm[lane]);
      rw[lane] = __expf(brow + ms - mtl);
      rw[64 + lane] = __expf(-mtl);
      rw[128 + lane] = __expf(brow - mtl);
    }
    __builtin_amdgcn_wave_barrier();
    float cf[2][8];
#pragma unroll
    for (int s2 = 0; s2 < 2; ++s2) {
      float4 c0 = *(const float4*)(sea + 32 * s2 + 8 * q), c1 = *(const float4*)(sea + 32 * s2 + 8 * q + 4);
      cf[s2][0] = c0.x; cf[s2][1] = c0.y; cf[s2][2] = c0.z; cf[s2][3] = c0.w;
      cf[s2][4] = c1.x; cf[s2][5] = c1.y; cf[s2][6] = c1.z; cf[s2][7] = c1.w;
    }
    bf16x8 cb0 = acc_frag(C[0], C[1]), cb1 = acc_frag(C[2], C[3]);
    bf16x8 nb0 = acc_frag(N[0], N[1]), nb1 = acc_frag(N[2], N[3]);
    bf16x8 vf0 = frag_nat(iVT, dvc, 0, q), vf1 = frag_nat(iVT, dvc, 1, q);
#pragma unroll
    for (int m = 0; m < 4; ++m) {
      int row = 16 * m + r;
      f32x4 qc = (f32x4){0.f, 0.f, 0.f, 0.f}, qn = qc;
      bf16x8 a0 = frag_perm(iQ, row, 0, q), a1 = frag_perm(iQ, row, 1, q);
      qc = MFMA16(a0, cb0, qc); qc = MFMA16(a1, cb1, qc);
      qn = MFMA16(a0, nb0, qn); qn = MFMA16(a1, nb1, qn);
      const float rfA = rw[128 + row];
      bf16x8 sf[2];
#pragma unroll
      for (int s2 = 0; s2 < 2; ++s2) {
        bf16x8 qkf = frag_nat(iQK, row, s2, q);
        float e[8];
#pragma unroll
        for (int j = 0; j < 8; ++j) {
          int jp = 32 * s2 + 8 * q + j;
          e[j] = (jp <= row) ? bf2f((u16)qkf[j]) * rfA * cf[s2][j] : 0.f;
        }
        u32x4_t w = {pack2(e[0], e[1]), pack2(e[2], e[3]), pack2(e[4], e[5]), pack2(e[6], e[7])};
        sf[s2] = __builtin_bit_cast(bf16x8, w);
      }
      const float4 wi4 = *(const float4*)(rw + 16 * m + 4 * q);
      const float4 em4 = *(const float4*)(rw + 64 + 16 * m + 4 * q);
      const float wi[4] = {wi4.x, wi4.y, wi4.z, wi4.w}, em[4] = {em4.x, em4.y, em4.z, em4.w};
      f32x4 num, den;
#pragma unroll
      for (int i = 0; i < 4; ++i) { num[i] = wi[i] * qc[i]; den[i] = wi[i] * qn[i]; }
      num = MFMA16(sf[0], vf0, num); num = MFMA16(sf[1], vf1, num);
      den = MFMA16(sf[0], ones, den); den = MFMA16(sf[1], ones, den);
#pragma unroll
      for (int i = 0; i < 4; ++i) {
        int tr = 16 * m + 4 * q + i;
        float dr = shl_(den[i], q * 16);
        float hv = num[i] * __builtin_amdgcn_rcpf(fmaxf(fabsf(dr), em[i]));
        int tg = ci * 64 + (dir ? 63 - tr : tr);
        O[(size_t)tg * 256 + h * 64 + dvc] = f2bf(hv);
      }
    }
    float mnew = fmaxf(blast + ms, blast + pmlast);
    float dec = __expf(blast + ms - mnew);
    const float ebl = __expf(blast - mnew);
    bf16x8 wv[2], wo[2];
#pragma unroll
    for (int s2 = 0; s2 < 2; ++s2) {
      bf16x8 vf = s2 ? vf1 : vf0;
      float wk[8], wvv[8];
#pragma unroll
      for (int j = 0; j < 8; ++j) { wk[j] = ebl * cf[s2][j]; wvv[j] = wk[j] * bf2f((u16)vf[j]); }
      u32x4_t w1 = {pack2(wvv[0], wvv[1]), pack2(wvv[2], wvv[3]), pack2(wvv[4], wvv[5]), pack2(wvv[6], wvv[7])};
      u32x4_t w2 = {pack2(wk[0], wk[1]), pack2(wk[2], wk[3]), pack2(wk[4], wk[5]), pack2(wk[6], wk[7])};
      if (r != 0) w2 = (u32x4_t){0u, 0u, 0u, 0u};
      wv[s2] = __builtin_bit_cast(bf16x8, w1);
      wo[s2] = __builtin_bit_cast(bf16x8, w2);
    }
#pragma unroll
    for (int t = 0; t < 4; ++t) {
      int row = 16 * t + r;
      bf16x8 k0 = frag_nat(iKT, row, 0, q), k1 = frag_nat(iKT, row, 1, q);
      f32x4 c = C[t] * dec, nn = N[t] * dec;
      c = MFMA16(k0, wv[0], c); c = MFMA16(k1, wv[1], c);
      nn = MFMA16(k0, wo[0], nn); nn = MFMA16(k1, wo[1], nn);
      C[t] = c; N[t] = nn;
    }
    __builtin_amdgcn_wave_barrier();
    ms = mnew;
  }
  if (seq < 16) {
    size_t sidx = (size_t)((seq * 2 + l) * 2 + dir) * 4 + h;
    float* oc = p.out + OUT_MC + sidx * 4096;
#pragma unroll
    for (int t = 0; t < 4; ++t)
#pragma unroll
      for (int i = 0; i < 4; ++i) oc[(16 * t + 4 * q + i) * 64 + dvc] = C[t][i];
    if (wave == 0 && r == 0) {
#pragma unroll
      for (int t = 0; t < 4; ++t)
#pragma unroll
        for (int i = 0; i < 4; ++i) p.out[OUT_MN + sidx * 64 + 16 * t + 4 * q + i] = N[t][i];
    }
    if (tid == 0) p.out[OUT_MM + sidx] = ms;
  }
}

__device__ void attn_item(const Params& p, int l, int seq, int head, int qb, char* smem) {
  const int tid = otid(), lane = tid & 63, wave = tid >> 6;
  const int r32 = lane & 31, hh = lane >> 5;
  const int qg = wave >> 1, c = wave & 1;
  const int Lk = seq_lk(seq);
  const int ntile = Lk / 64;
  const size_t kr0 = krow0(seq, head);
  const u16* Kb = (const u16*)(p.ws + OFF_K) + kr0 * 128;
  const u16* Vb = (const u16*)(p.ws + OFF_VT) + kr0 * 128;
  u16* Q = (u16*)(p.ws + OFF_Q);
  const int tq = seq_tok0(seq) + qb * 64 + qg * 32 + r32;
  bf16x8 qf[4];
#pragma unroll
  for (int ks = 0; ks < 4; ++ks) qf[ks] = *(const bf16x8*)(Q + (size_t)tq * 512 + head * 128 + c * 64 + ks * 16 + hh * 8);
  f32x16 O[4];
#pragma unroll
  for (int d = 0; d < 4; ++d)
#pragma unroll
    for (int i = 0; i < 16; ++i) O[d][i] = 0.f;
  float mrun = -1.0e30f, lrun = 0.f;

  const unsigned koff0 = (unsigned)((wave * 4 + (lane >> 4)) * 256 + (((lane & 15) ^ ((wave * 4 + (lane >> 4)) & 15)) * 16));
  const unsigned voff0 = (unsigned)((wave * 8 + (lane >> 3)) * Lk * 2 + (((lane & 7) ^ ((wave * 4 + (lane >> 4)) & 7)) * 16));
  const unsigned ldst0 = (unsigned)(wave * 1024 + lane * 16);
  uint4 sg0, sg1, sg2, sg3;
  auto issue = [&](int kt, int buf) {
    char* sK = smem + buf * 32768 + ldst0;
    const unsigned ko = koff0 + (unsigned)kt * 16384u;
#pragma unroll
    for (int i = 0; i < 4; ++i) glds16((const char*)Kb + (ko + (unsigned)(i * 4096)), sK + i * 4096);
  };
#define VLOAD(kt_) do { const unsigned vo_ = voff0 + (unsigned)(kt_) * 128u; const char* vb_ = (const char*)Vb; \
    sg0 = *(const uint4*)(vb_ + vo_); sg1 = *(const uint4*)(vb_ + (vo_ + (unsigned)(64 * Lk))); \
    sg2 = *(const uint4*)(vb_ + (vo_ + (unsigned)(128 * Lk))); sg3 = *(const uint4*)(vb_ + (vo_ + (unsigned)(192 * Lk))); } while (0)
#define VSTORE(buf_) do { char* sV_ = smem + (buf_) * 32768 + 16384 + ldst0; \
    *(uint4*)(sV_) = sg0; *(uint4*)(sV_ + 4096) = sg1; *(uint4*)(sV_ + 8192) = sg2; *(uint4*)(sV_ + 12288) = sg3; } while (0)
  __syncthreads();
  issue(0, 0);
  VLOAD(0);
  VSTORE(0);
  for (int kt = 0; kt < ntile; ++kt) {
    wait_vm0();
    __syncthreads();
    if (kt + 1 < ntile) { issue(kt + 1, (kt + 1) & 1); VLOAD(kt + 1); }
    const unsigned bufo = (unsigned)(kt & 1) * 32768u;
    f32x16 Sx[2];
#pragma unroll
    for (int half = 0; half < 2; ++half) {
      const unsigned kx = bufo + (unsigned)(32 * half + r32) * 256u + (unsigned)c * 128u, kswz = (unsigned)(r32 & 15) << 4;
      bf16x8 ka[4];
#pragma unroll
      for (int ks = 0; ks < 4; ++ks) ka[ks] = *(const bf16x8*)(smem + ((kx + (unsigned)((2 * ks + hh) * 16)) ^ kswz));
#pragma unroll
      for (int i = 0; i < 16; ++i) Sx[half][i] = 0.f;
#pragma unroll
      for (int ks = 0; ks < 4; ++ks) Sx[half] = MFMA32(ka[ks], qf[ks], Sx[half]);
    }
#pragma unroll
    for (int half = 0; half < 2; ++half) {
      bf16x8 pf[2];
      bf16x8 vfr[4][2];
#pragma unroll
      for (int d = 0; d < 4; ++d) {
        const int row = 32 * d + r32;
        const unsigned vswz = (unsigned)((row >> 1) & 7) << 4;
        const unsigned vx = bufo + 16384u + (unsigned)row * 128u + 16u * (unsigned)hh + (unsigned)half * 64u;
#pragma unroll
        for (int s2 = 0; s2 < 2; ++s2) vfr[d][s2] = *(const bf16x8*)(smem + ((vx + (unsigned)(s2 * 32)) ^ vswz));
      }
      __builtin_amdgcn_sched_barrier(0);
      float mx = Sx[half][0];
#pragma unroll
      for (int i = 1; i < 16; ++i) mx = fmaxf(mx, Sx[half][i]);
      mx = fmaxf(mx, shx(mx, 32, lane));
      float mnew = fmaxf(mrun, mx);
      const bool grow = __builtin_amdgcn_ballot_w64(mnew > mrun) != 0ull;
      float ps = 0.f;
#pragma unroll
      for (int i = 0; i < 16; ++i) { float e = __builtin_amdgcn_exp2f(Sx[half][i] - mnew); Sx[half][i] = e; ps += e; }
      if (grow) {
        float alpha = __builtin_amdgcn_exp2f(mrun - mnew);
        mrun = mnew;
        lrun *= alpha;
#pragma unroll
        for (int d = 0; d < 4; ++d)
#pragma unroll
          for (int i = 0; i < 16; ++i) O[d][i] *= alpha;
      }
      lrun += ps;
#pragma unroll
      for (int s2 = 0; s2 < 2; ++s2) {
        u32x4_t w = {pack2(Sx[half][8 * s2], Sx[half][8 * s2 + 1]), pack2(Sx[half][8 * s2 + 2], Sx[half][8 * s2 + 3]),
                     pack2(Sx[half][8 * s2 + 4], Sx[half][8 * s2 + 5]), pack2(Sx[half][8 * s2 + 6], Sx[half][8 * s2 + 7])};
        pf[s2] = __builtin_bit_cast(bf16x8, w);
      }
      __builtin_amdgcn_sched_barrier(0);
#pragma unroll
      for (int d = 0; d < 4; ++d)
#pragma unroll
        for (int s2 = 0; s2 < 2; ++s2) O[d] = MFMA32(vfr[d][s2], pf[s2], O[d]);
    }
    if (kt + 1 < ntile) VSTORE((kt + 1) & 1);
  }
  const int tid2 = otid();
  const int lane2 = tid2 & 63, r32b = lane2 & 31, hhb = lane2 >> 5, qgb = tid2 >> 7, cb = (tid2 >> 6) & 1;
  const int tqb = seq_tok0(seq) + qb * 64 + qgb * 32 + r32b;
  float lsum = lrun + shx(lrun, 32, lane2);
  const int l2 = *(volatile LAS int*)(LAS int*)(smem + LDS_CTL + 4);
  const float lam = ((const float*)(p.ws + OFF_LAM))[l2];
  const float lam_init = l2 == 0 ? 0.2f : 0.35550907f;
  float inv = (cb == 0 ? 1.f : lam) / lsum;
  float* xch = (float*)smem + qgb * (32 * 132) + r32b * 132;
  __syncthreads();
  if (cb == 1) {
#pragma unroll
    for (int d = 0; d < 4; ++d)
#pragma unroll
      for (int g = 0; g < 4; ++g) {
        int dv = 32 * d + 8 * g + 4 * hhb;
        *(float4*)(xch + dv) = make_float4(O[d][4 * g] * inv, O[d][4 * g + 1] * inv, O[d][4 * g + 2] * inv, O[d][4 * g + 3] * inv);
      }
  }
  __syncthreads();
  if (cb == 0) {
    float ss = 0.f;
#pragma unroll
    for (int d = 0; d < 4; ++d)
#pragma unroll
      for (int g = 0; g < 4; ++g) {
        int dv = 32 * d + 8 * g + 4 * hhb;
        float4 o1 = *(const float4*)(xch + dv);
        float v0 = O[d][4 * g] * inv - o1.x, v1 = O[d][4 * g + 1] * inv - o1.y;
        float v2 = O[d][4 * g + 2] * inv - o1.z, v3 = O[d][4 * g + 3] * inv - o1.w;
        O[d][4 * g] = v0; O[d][4 * g + 1] = v1; O[d][4 * g + 2] = v2; O[d][4 * g + 3] = v3;
        ss += v0 * v0 + v1 * v1 + v2 * v2 + v3 * v3;
      }
    ss += shx(ss, 32, lane2);
    float rs = rsqrtf(ss * (1.f / 128.f) + EPSF) * (1.f - lam_init);
    const float* ag = p.in[18] + l2 * 128;
#pragma unroll
    for (int d = 0; d < 4; ++d)
#pragma unroll
      for (int g = 0; g < 4; ++g) {
        int dv = 32 * d + 8 * g + 4 * hhb;
        float4 gg = *(const float4*)(ag + dv);
        uint2 o;
        o.x = pack2(O[d][4 * g + 0] * rs * gg.x, O[d][4 * g + 1] * rs * gg.y);
        o.y = pack2(O[d][4 * g + 2] * rs * gg.z, O[d][4 * g + 3] * rs * gg.w);
        *(uint2*)(Q + (size_t)tqb * 512 + head * 128 + dv) = o;
      }
  }
}

__device__ void merge_phase(const Params& p, int l, int bid, int nb) {
  const int tid_ = otid();
  const int wave = tid_ >> 6, lane = tid_ & 63;
  const u16* Od = (const u16*)(p.ws + OFF_BPRE);
  const u16* Om = (const u16*)(p.ws + OFF_MOM);
  const u16* BG = (const u16*)(p.ws + OFF_BG);
  const u16* CO = (const u16*)(p.ws + OFF_CO);
  u16* cat2 = (u16*)(p.ws + OFF_U);
  const float* dg = p.in[22] + l * 64;
  const float* mg = p.in[24] + l * 64;
  for (int t = bid * 4 + wave; t < NT; t += nb * 4) {
    int c = lane * 4;
    uint2 a = *(const uint2*)(Od + (size_t)t * 256 + c), b = *(const uint2*)(Od + (size_t)(NT + t) * 256 + c);
    uint2 gt = *(const uint2*)(BG + (size_t)t * 256 + c);
    float v[4] = {bf2f(a.x & 0xffff) + bf2f(b.x & 0xffff), bf2f(a.x >> 16) + bf2f(b.x >> 16),
                  bf2f(a.y & 0xffff) + bf2f(b.y & 0xffff), bf2f(a.y >> 16) + bf2f(b.y >> 16)};
    float g[4] = {bf2f(gt.x & 0xffff), bf2f(gt.x >> 16), bf2f(gt.y & 0xffff), bf2f(gt.y >> 16)};
    float ss = v[0] * v[0] + v[1] * v[1] + v[2] * v[2] + v[3] * v[3];
#pragma unroll
    for (int o = 8; o > 0; o >>= 1) ss += shx(ss, o, lane);
    float rs = rsqrtf(ss * (1.f / 64.f) + EPSF);
    float4 w = *(const float4*)(dg + (c & 63));
    uint2 o;
    o.x = pack2(v[0] * rs * w.x * siluf(g[0]), v[1] * rs * w.y * siluf(g[1]));
    o.y = pack2(v[2] * rs * w.z * siluf(g[2]), v[3] * rs * w.w * siluf(g[3]));
    *(uint2*)(cat2 + (size_t)t * 512 + c) = o;
    a = *(const uint2*)(Om + (size_t)t * 256 + c); b = *(const uint2*)(Om + (size_t)(NT + t) * 256 + c);
    gt = *(const uint2*)(CO + (size_t)t * 256 + c);
    float v2[4] = {bf2f(a.x & 0xffff) + bf2f(b.x & 0xffff), bf2f(a.x >> 16) + bf2f(b.x >> 16),
                   bf2f(a.y & 0xffff) + bf2f(b.y & 0xffff), bf2f(a.y >> 16) + bf2f(b.y >> 16)};
    float g2[4] = {bf2f(gt.x & 0xffff), bf2f(gt.x >> 16), bf2f(gt.y & 0xffff), bf2f(gt.y >> 16)};
    ss = v2[0] * v2[0] + v2[1] * v2[1] + v2[2] * v2[2] + v2[3] * v2[3];
#pragma unroll
    for (int o2 = 8; o2 > 0; o2 >>= 1) ss += shx(ss, o2, lane);
    rs = rsqrtf(ss * (1.f / 64.f) + EPSF);
    w = *(const float4*)(mg + (c & 63));
    o.x = pack2(v2[0] * rs * w.x * sigmf(g2[0]), v2[1] * rs * w.y * sigmf(g2[1]));
    o.y = pack2(v2[2] * rs * w.z * sigmf(g2[2]), v2[3] * rs * w.w * sigmf(g2[3]));
    *(uint2*)(cat2 + (size_t)t * 512 + 256 + c) = o;
  }
}

__device__ void final_norm(const Params& p, int bid, int nb) {
  const int tid_ = otid();
  const int wave = tid_ >> 6, lane = tid_ & 63;
  const float* g = p.in[27];
  for (int t = bid * 4 + wave; t < NT; t += nb * 4) {
    float* x = p.out + (size_t)t * DM;
    float4 v[4];
    float ss = 0.f;
#pragma unroll
    for (int i = 0; i < 4; ++i) {
      v[i] = *(const float4*)(x + i * 256 + lane * 4);
      ss += v[i].x * v[i].x + v[i].y * v[i].y + v[i].z * v[i].z + v[i].w * v[i].w;
    }
    ss = wave_sum(ss, lane);
    float rs = rsqrtf(ss * (1.f / 1024.f) + EPSF);
#pragma unroll
    for (int i = 0; i < 4; ++i) {
      float4 gg = *(const float4*)(g + i * 256 + lane * 4);
      float4 o = make_float4(v[i].x * rs * gg.x, v[i].y * rs * gg.y, v[i].z * rs * gg.z, v[i].w * rs * gg.w);
      *(float4*)(x + i * 256 + lane * 4) = o;
    }
  }
}

__device__ void mixer_queue(const Params& p, int l, char* smem, int xcc) {
  int& s_item = *(int*)(smem + LDS_CTL);
  if (otid() == 0) *(volatile LAS int*)(LAS int*)(smem + LDS_CTL + 4) = l;
#pragma unroll 1
  for (int qi = 0; qi < 8; ++qi) {
    const int qx = (xcc + qi) & 7;
    unsigned* cnt = (unsigned*)(p.ws + OFF_CNT) + __builtin_amdgcn_readfirstlane(l * 8 + qx);
    for (;;) {
      __syncthreads();
      if (otid() == 0) s_item = (int)atomicAdd(cnt, 1u);
      __syncthreads();
      int u = __builtin_amdgcn_readfirstlane(s_item);
      if (u >= 200) break;
      int kind, seq, a1, a2;
      if (u < 8) { int idx = qx * 4 + (u >> 1); kind = u & 1; seq = 16 + (idx >> 3); a1 = (idx >> 1) & 3; a2 = idx & 1; }
      else if (u < 136) { int j = u - 8; int pair = 2 * qx + (j >> 6); kind = 2; seq = 16 + (pair >> 2); a1 = pair & 3; a2 = j & 63; }
      else if (u < 168) { int g = qx * 32 + (u - 136); int idx = g >> 1; kind = g & 1; seq = idx >> 3; a1 = (idx >> 1) & 3; a2 = idx & 1; }
      else { int g = qx * 32 + (u - 168); kind = 2; seq = g >> 4; a1 = (g >> 2) & 3; a2 = g & 3; }
      if (kind == 0) delta_scan(p, l, seq, a1, a2, smem);
      else if (kind == 1) mlstm_scan(p, l, seq, a1, a2, smem);
      else attn_item(p, l, seq, a1, a2, smem);
    }
  }
}

__global__ void __launch_bounds__(256, 2) mega(Params p0) {
  extern __shared__ __attribute__((aligned(16))) char smem[];
  const int bid = blockIdx.x, nb = gridDim.x;
  if (threadIdx.x == 0) { *(volatile LAS unsigned*)(LAS unsigned*)(smem + LDS_CTL + 8) = 0u; *(volatile LAS unsigned*)(LAS unsigned*)(smem + LDS_CTL + 12) = 0u; }
  __syncthreads();
  const XcdBarrier xb = xcd_barrier_post((unsigned*)(p0.ws + OFF_BAR), (volatile LAS unsigned*)(LAS unsigned*)(smem + LDS_CTL + 8));
  if (p0.rep[3] < 0) cg::this_grid().sync();

#pragma unroll 1
  for (int ph = 0; ph < 20; ++ph) {
    const Params& p = p0;
    const int l = ph < 10 ? 0 : 1;
    const int k = ph == 0 ? -1 : (ph == 19 ? 9 : (ph - 1) % 9);
    switch (k) {
      case -1:
        for (int t = bid; t < 192; t += nb) mod_task(p, t, smem);
        if (bid == nb - 1) misc_task(p);
        wconv_job(p.in[14], (u16*)(p.ws + OFF_WIN), 1024, INW, INP, 1, smem, bid, nb);
        break;
      case 0:
        norm_phase(p, l, 0, bid, nb);
        cache_conv(p, l, smem, bid, nb);
        break;
      case 1:
        gemm_phase<EPI_IN>(p, l, (const u16*)(p.ws + OFF_U), 1024, (const u16*)(p.ws + OFF_U), 1024, 1 << 30,
                           (const u16*)(p.ws + OFF_WIN), 1024, INP / 128, smem, bid, nb);
        break;
      case 2:
        for (int it = bid; it < 1280; it += nb) prep_item(p, l, it >> 2, it & 3, smem);
        break;
      case 3:
        mixer_queue(p, l, smem, (int)(xb.x & 7u));
        break;
      case 4:
        merge_phase(p, l, bid, nb);
        wconv_job(p.in[16] + (size_t)l * 1024 * 1024, (u16*)(p.ws + OFF_WOUT), 1024, 1024, 1024, 0, smem, bid, nb);
        wconv_job(p.in[25] + (size_t)l * 1024 * 2 * FF, (u16*)(p.ws + OFF_WGU), 1024, 2 * FF, 2 * FF, 2, smem, bid, nb);
        wconv_job(p.in[26] + (size_t)l * FF * 1024, (u16*)(p.ws + OFF_WDN), FF, 1024, 1024, 0, smem, bid, nb);
        if (l == 0) wconv_job(p.in[14] + (size_t)1024 * INW, (u16*)(p.ws + OFF_WIN), 1024, INW, INP, 1, smem, bid, nb);
        break;
      case 5:
        gemm_phase<EPI_RES1>(p, l, (const u16*)(p.ws + OFF_Q), 512, (const u16*)(p.ws + OFF_U), 512, 512,
                             (const u16*)(p.ws + OFF_WOUT), 1024, 8, smem, bid, nb);
        break;
      case 6:
        norm_phase(p, l, 1, bid, nb);
        break;
      case 7:
        gemm_phase_big<EPI_SWIGLU>(p, l, (const u16*)(p.ws + OFF_U), 1024, (const u16*)(p.ws + OFF_WGU), 1024, 2 * FF / 128, smem, bid, nb);
        break;
      case 8:
        gemm_phase<EPI_RES2>(p, l, (const u16*)(p.ws), FF, (const u16*)(p.ws), FF, 1 << 30,
                             (const u16*)(p.ws + OFF_WDN), FF, 8, smem, bid, nb);
        break;
      default:
        final_norm(p, bid, nb);
        break;
    }
    if (ph < 19) xcd_barrier(xb);
  }
}

extern "C" void kernel_launch(void* const* d_in, const int* in_sizes, int n_in, void* d_out, int out_size,
                              void* d_ws, size_t ws_size, hipStream_t stream) {
  static int grid_blocks = 0;
  if (!grid_blocks) {
    int dev = 0, cus = 0, per_cu = 0;
    (void)hipGetDevice(&dev);
    (void)hipDeviceGetAttribute(&cus, hipDeviceAttributeMultiprocessorCount, dev);
    (void)hipFuncSetAttribute((const void*)mega, hipFuncAttributeMaxDynamicSharedMemorySize, LDS_BYTES);
    (void)hipOccupancyMaxActiveBlocksPerMultiprocessor(&per_cu, mega, 256, LDS_BYTES);
    if (per_cu > 2) per_cu = 2;
    if (per_cu < 1) per_cu = 1;
    grid_blocks = cus * per_cu;
  }
  if (ws_size < WS_NEED) { fprintf(stderr, "workspace too small: %zu < %zu\n", ws_size, (size_t)WS_NEED); return; }
  Params p{};
  for (int i = 0; i < 28; ++i) p.in[i] = (const float*)d_in[i];
  p.out = (float*)d_out;
  p.ws = (char*)d_ws;
  p.rep[0] = REP0; p.rep[1] = REP1; p.rep[2] = REP2; p.rep[3] = REP3;
  (void)hipMemsetAsync((char*)d_ws + OFF_BAR, 0, (size_t)XCD_BAR_WORDS_C * 4, stream);
  void* args[] = {&p};
  hipError_t e = hipLaunchCooperativeKernel((void*)mega, dim3(grid_blocks), dim3(256), args, LDS_BYTES, stream);
  if (e != hipSuccess) fprintf(stderr, "cooperative launch failed: %s (grid %d)\n", hipGetErrorString(e), grid_blocks);
}
```
